# Optimizing an MI355X kernel written in HIP

```python
import jax, jax.numpy as jnp
from jax import lax
import numpy as np

D_MODEL = 2048
BATCH = 4
SEQ = 2048
DEPTH = 1

CHUNK = 64
SGU_BLOCK = 128
SGU_WIDTH = 2048
SGU_GROUPS = 8
SGU_GROUP_DIM = SGU_WIDTH // SGU_GROUPS
MLSTM_WIDTH = 2048
MLSTM_HEADS = 4
MLSTM_HEAD_DIM = MLSTM_WIDTH // MLSTM_HEADS
CONV_WIDTH = 4
N_EXPERTS = 32
TOP_K = 4
D_FF = 2048
SWIGLU_LIMIT = 7.0
SWIGLU_ALPHA = 1.702
EPS = 1e-6

COL_SIZES = (SGU_WIDTH, SGU_WIDTH,
             MLSTM_WIDTH, MLSTM_WIDTH, MLSTM_WIDTH,
             MLSTM_WIDTH,
             MLSTM_HEADS, MLSTM_HEADS,
             D_MODEL, D_MODEL)
IN_COLS = 2 * SGU_WIDTH + 4 * MLSTM_WIDTH + 2 * MLSTM_HEADS + 2 * D_MODEL
F_GATE_OFF = 2 * SGU_WIDTH + 4 * MLSTM_WIDTH + MLSTM_HEADS

kernel_name = "hybrid_gmlp_mlstm_moe_block"


def rmsnorm(x, g):
    xf = x.astype(jnp.float32)
    y = xf * lax.rsqrt(jnp.mean(xf * xf, axis=-1, keepdims=True) + EPS)
    return (y * g.astype(jnp.float32)).astype(x.dtype)


def layernorm(x, g, b):
    xf = x.astype(jnp.float32)
    mu = jnp.mean(xf, axis=-1, keepdims=True)
    var = jnp.mean(jnp.square(xf - mu), axis=-1, keepdims=True)
    y = (xf - mu) * lax.rsqrt(var + EPS)
    return (y * g.astype(jnp.float32) + b.astype(jnp.float32)).astype(x.dtype)


def split_columns(z):
    idx = np.cumsum(np.array(COL_SIZES))[:-1].tolist()
    return jnp.split(z, idx, axis=-1)


def causal_conv(x, w, b):
    s = x.shape[1]
    xp = jnp.pad(x, ((0, 0), (CONV_WIDTH - 1, 0), (0, 0)))
    y = xp[:, 0:s] * w[0]
    for j in range(1, CONV_WIDTH):
        y = y + xp[:, j:j + s] * w[j]
    return y + b


def spatial_gating(u, v, w_s, b_s, g_ln, b_ln):
    bsz, s, _ = v.shape
    v = layernorm(v, g_ln, b_ln)
    nb = s // SGU_BLOCK
    vb = v.reshape(bsz, nb, SGU_BLOCK, SGU_GROUPS, SGU_GROUP_DIM)
    chunk_id = jnp.arange(SGU_BLOCK) // CHUNK
    mask = chunk_id[None, :] <= chunk_id[:, None]
    w = jnp.where(mask[None], w_s, 0)
    mixed = jnp.einsum('gts,bnsgd->bntgd', w, vb) + b_s.T[None, None, :, :, None]
    return u * mixed.reshape(bsz, s, SGU_WIDTH)


def mlstm_chunkwise(q, k, v, ig, fg):
    out_dtype = q.dtype
    q, k, v, ig, fg = (a.astype(jnp.float32) for a in (q, k, v, ig, fg))
    bsz, nh, s, dh = q.shape
    nc = s // CHUNK
    q = q * (dh ** -0.5)
    logf = jax.nn.log_sigmoid(fg)

    def to_chunks(a):
        a = a.reshape(a.shape[:2] + (nc, CHUNK) + a.shape[3:])
        return jnp.moveaxis(a, 2, 0)

    xs = (to_chunks(q), to_chunks(k), to_chunks(v), to_chunks(ig), to_chunks(logf))
    tril = jnp.tril(jnp.ones((CHUNK, CHUNK), dtype=bool))

    def step(carry, inp):
        c_st, n_st, m_st = carry
        qi, ki, vi, igi, lfi = inp
        bcum = jnp.cumsum(lfi, axis=-1)
        dlog = bcum[..., :, None] - bcum[..., None, :] + igi[..., None, :]
        dlog = jnp.where(tril, dlog, -jnp.inf)
        m_inter = bcum + m_st[..., None]
        m_t = jnp.maximum(m_inter, jnp.max(dlog, axis=-1))
        sc = jnp.einsum('bhtd,bhsd->bhts', qi, ki) * jnp.exp(dlog - m_t[..., None])
        inter = jnp.exp(m_inter - m_t)
        num = jnp.einsum('bhts,bhsd->bhtd', sc, vi) + inter[..., None] * jnp.einsum('bhtk,bhvk->bhtv', qi, c_st)
        den = jnp.sum(sc, axis=-1) + inter * jnp.einsum('bhtk,bhk->bht', qi, n_st)
        h = num / jnp.maximum(jnp.abs(den), jnp.exp(-m_t))[..., None]
        g_tot = bcum[..., -1]
        a = g_tot[..., None] - bcum + igi
        m_new = jnp.maximum(g_tot + m_st, jnp.max(a, axis=-1))
        wa = jnp.exp(a - m_new[..., None])
        decay = jnp.exp(g_tot + m_st - m_new)
        c_new = decay[..., None, None] * c_st + jnp.einsum('bhs,bhsv,bhsk->bhvk', wa, vi, ki)
        n_new = decay[..., None] * n_st + jnp.einsum('bhs,bhsk->bhk', wa, ki)
        return (c_new, n_new, m_new), h

    init = (jnp.zeros((bsz, nh, dh, dh), jnp.float32),
            jnp.zeros((bsz, nh, dh), jnp.float32),
            jnp.zeros((bsz, nh), jnp.float32))
    _, hs = lax.scan(step, init, xs)
    h = jnp.moveaxis(hs, 0, 2).reshape(bsz, nh, s, dh)
    return h.astype(out_dtype)


def hybrid_mixer(h, w_in, b_in, w_conv, b_conv, w_sgu, b_sgu, g_sgu_ln, b_sgu_ln,
                 g_mlstm_norm, w_proj_sgu, w_proj_mlstm, w_out):
    bsz, s, _ = h.shape
    z = h @ w_in + b_in
    u, v, qm, km, vm, om, ig, fg, ga, gm = split_columns(z)
    y_a = spatial_gating(jax.nn.gelu(u, approximate=False), jax.nn.gelu(v, approximate=False),
                         w_sgu, b_sgu, g_sgu_ln, b_sgu_ln)
    qk = jax.nn.silu(causal_conv(jnp.concatenate([qm, km], axis=-1), w_conv, b_conv))
    qm, km = jnp.split(qk, 2, axis=-1)

    def heads(a):
        return a.reshape(bsz, s, MLSTM_HEADS, MLSTM_HEAD_DIM).transpose(0, 2, 1, 3)

    hm = mlstm_chunkwise(heads(qm), heads(km), heads(vm), ig.transpose(0, 2, 1), fg.transpose(0, 2, 1))
    hm = rmsnorm(hm.transpose(0, 2, 1, 3), g_mlstm_norm.reshape(MLSTM_HEADS, MLSTM_HEAD_DIM))
    y_m = hm.reshape(bsz, s, MLSTM_WIDTH) * jax.nn.sigmoid(om)
    merged = jax.nn.sigmoid(ga) * (y_a @ w_proj_sgu) + jax.nn.sigmoid(gm) * (y_m @ w_proj_mlstm)
    return merged @ w_out


def moe_ffn(h, w_router, b_router, w_gate_up, b_gate_up, w_down, b_down):
    bsz, s, d = h.shape
    t = h.reshape(bsz * s, d)
    logits = (t @ w_router + b_router).astype(jnp.float32)
    top_vals, top_idx = lax.top_k(logits, TOP_K)
    probs = jax.nn.softmax(top_vals, axis=-1)
    gates = jnp.sum(jax.nn.one_hot(top_idx, N_EXPERTS, dtype=jnp.float32) * probs[..., None], axis=1)
    out = jnp.zeros((bsz * s, d), jnp.float32)
    for e in range(N_EXPERTS):
        gu = t @ w_gate_up[e] + b_gate_up[e]
        gate, up = gu[:, :D_FF], gu[:, D_FF:]
        gate = jnp.minimum(gate, SWIGLU_LIMIT)
        up = jnp.clip(up, -SWIGLU_LIMIT, SWIGLU_LIMIT)
        act = (up + 1) * (gate * jax.nn.sigmoid(SWIGLU_ALPHA * gate))
        y_e = act @ w_down[e] + b_down[e]
        out = out + gates[:, e:e + 1] * y_e.astype(jnp.float32)
    return out.reshape(bsz, s, d).astype(h.dtype)


def setup_inputs(seed: int = 0) -> dict:
    key = jax.random.key(seed)
    ks = jax.random.split(key, 24)
    L, D, E, F = DEPTH, D_MODEL, N_EXPERTS, D_FF

    def nrm(k, shape, scale):
        return jax.random.normal(k, shape, jnp.float32) * scale

    b_in = nrm(ks[3], (L, IN_COLS), 0.02)
    b_in = b_in.at[:, F_GATE_OFF:F_GATE_OFF + MLSTM_HEADS].add(jnp.linspace(3.0, 6.0, MLSTM_HEADS))
    return {
        "x": nrm(ks[0], (BATCH, SEQ, D), 1.0),
        "g_norm_mix": 1.0 + nrm(ks[1], (L, D), 0.02),
        "w_in": nrm(ks[2], (L, D, IN_COLS), D ** -0.5),
        "b_in": b_in,
        "w_conv": nrm(ks[4], (L, CONV_WIDTH, 2 * MLSTM_WIDTH), CONV_WIDTH ** -0.5),
        "b_conv": nrm(ks[5], (L, 2 * MLSTM_WIDTH), 0.02),
        "w_sgu": nrm(ks[6], (L, SGU_GROUPS, SGU_BLOCK, SGU_BLOCK), SGU_BLOCK ** -0.5),
        "b_sgu": 1.0 + nrm(ks[7], (L, SGU_GROUPS, SGU_BLOCK), 0.02),
        "g_sgu_ln": 1.0 + nrm(ks[8], (L, SGU_WIDTH), 0.02),
        "b_sgu_ln": nrm(ks[9], (L, SGU_WIDTH), 0.02),
        "g_mlstm_norm": 1.0 + nrm(ks[10], (L, MLSTM_WIDTH), 0.02),
        "w_proj_sgu": nrm(ks[11], (L, SGU_WIDTH, D), SGU_WIDTH ** -0.5),
        "w_proj_mlstm": nrm(ks[12], (L, MLSTM_WIDTH, D), MLSTM_WIDTH ** -0.5),
        "w_out": nrm(ks[13], (L, D, D), D ** -0.5),
        "g_norm_moe": 1.0 + nrm(ks[14], (L, D), 0.02),
        "w_router": nrm(ks[15], (L, D, E), D ** -0.5),
        "b_router": nrm(ks[16], (L, E), 0.01),
        "w_gate_up": nrm(ks[17], (L, E, D, 2 * F), D ** -0.5),
        "b_gate_up": nrm(ks[18], (L, E, 2 * F), 0.02),
        "w_down": nrm(ks[19], (L, E, F, D), F ** -0.5),
        "b_down": nrm(ks[20], (L, E, D), 0.02),
        "g_final": 1.0 + nrm(ks[21], (D,), 0.02),
    }


def reference(x, g_norm_mix, w_in, b_in, w_conv, b_conv, w_sgu, b_sgu, g_sgu_ln, b_sgu_ln,
              g_mlstm_norm, w_proj_sgu, w_proj_mlstm, w_out, g_norm_moe, w_router, b_router,
              w_gate_up, b_gate_up, w_down, b_down, g_final):
    for l in range(DEPTH):
        h = rmsnorm(x, g_norm_mix[l])
        x = x + hybrid_mixer(h, w_in[l], b_in[l], w_conv[l], b_conv[l], w_sgu[l], b_sgu[l],
                             g_sgu_ln[l], b_sgu_ln[l], g_mlstm_norm[l], w_proj_sgu[l],
                             w_proj_mlstm[l], w_out[l]).astype(x.dtype)
        h = rmsnorm(x, g_norm_moe[l])
        x = x + moe_ffn(h, w_router[l], b_router[l], w_gate_up[l], b_gate_up[l],
                        w_down[l], b_down[l]).astype(x.dtype)
    return rmsnorm(x, g_final)
```

```cpp
#include <hip/hip_runtime.h>
#include <cstdio>
#include <cstdint>

#ifndef MK_N_LAUNCHES
#define MK_N_LAUNCHES 1
#endif

#define GAS __attribute__((address_space(1)))
#define LAS __attribute__((address_space(3)))
typedef unsigned short bf16;
typedef short bf16x8 __attribute__((ext_vector_type(8)));
typedef short bf16x16 __attribute__((ext_vector_type(16)));
typedef int i32x8 __attribute__((ext_vector_type(8)));
typedef int i32x4 __attribute__((ext_vector_type(4)));
typedef float f32x4 __attribute__((ext_vector_type(4)));
typedef float f32x2 __attribute__((ext_vector_type(2)));
typedef unsigned u32x4 __attribute__((ext_vector_type(4)));
typedef unsigned u32x2 __attribute__((ext_vector_type(2)));

constexpr int D = 2048, NB = 4, SEQ = 2048, T = NB * SEQ;
constexpr int INC = 16392;
constexpr int NH = 4, DH = 512, NE = 32, TOPK = 4, FF = 2048, CAP = 8192;
constexpr int N_BF16_TILES = 40, N_FP8_TILES = 24;
constexpr float EPS = 1e-6f;
constexpr int NWAVES = 8, NTHR = 512;

constexpr size_t MiB = 1u << 20;
constexpr size_t WS_CTL = 0, CTL_ZERO_BYTES = 128 * 1024;
constexpr size_t CTLB_ECNT = 32 * 1024;
constexpr size_t CTLB_TMO = 48 * 1024;
constexpr size_t CTLB_HCNT = 64 * 1024;
constexpr size_t WS_G8 = 1 * MiB;
constexpr size_t WS_AS = WS_G8 + 512 * 1024;
constexpr size_t WS_MT = WS_AS + 128 * 1024;
constexpr size_t WS_BM = WS_MT + 128 * 1024;
constexpr size_t WS_SLOT = 2 * MiB;
constexpr size_t WS_WBD = 3 * MiB;
constexpr size_t WS_WIN = 4 * MiB;
constexpr size_t WS_PAM = WS_WIN + 64 * MiB;
constexpr size_t WS_WOUT = WS_PAM + 16 * MiB;
constexpr size_t WS_WGU = WS_WOUT + 8 * MiB;
constexpr size_t WS_WD = WS_WGU + 512 * MiB;
constexpr size_t WS_H = WS_WD + 256 * MiB;
constexpr size_t WS_UG = WS_H + 32 * MiB;
constexpr size_t WS_VGT = WS_UG + 32 * MiB;
constexpr size_t WS_QKR = WS_VGT + 32 * MiB;
constexpr size_t WS_QKC = WS_QKR + 64 * MiB;
constexpr size_t WS_VMT = WS_QKC + 64 * MiB;
constexpr size_t WS_OG = WS_VMT + 32 * MiB;
constexpr size_t WS_GA = WS_OG + 32 * MiB;
constexpr size_t WS_GM = WS_GA + 32 * MiB;
constexpr size_t WS_P = WS_GM + 32 * MiB;
constexpr size_t WS_HM = WS_P + 128 * MiB;
constexpr size_t WS_Y = WS_HM + 32 * MiB;
constexpr size_t WS_MRG = WS_Y + 64 * MiB;
constexpr size_t WS_X1 = WS_MRG + 32 * MiB;
constexpr size_t WS_XS = WS_X1 + 64 * MiB;
constexpr size_t WS_HA = WS_XS + 512 * MiB;
constexpr size_t WS_YE = WS_XS + 1024 * MiB;
constexpr size_t WS_DENP = WS_YE + 1024 * MiB;
constexpr size_t WS_VPART = WS_DENP + 4 * MiB;
constexpr size_t WS_SSQP = WS_VPART + 2 * MiB;
constexpr size_t WS_H8 = WS_SSQP + 1 * MiB;
constexpr size_t WS_WIN8 = WS_H8 + 16 * MiB;
constexpr size_t WS_END = WS_WIN8 + 12 * MiB;

constexpr int RING_BYTES = 131072;
constexpr int MISC_OFF = RING_BYTES;
constexpr int LDS_BYTES = 147456;

#define LDS_WAIT() asm volatile("s_waitcnt lgkmcnt(0)" ::: "memory")
#define VM_WAIT() asm volatile("s_waitcnt vmcnt(0)" ::: "memory")

__device__ __forceinline__ unsigned f2bf(float f) { unsigned u = __builtin_bit_cast(unsigned, f); return (u + 0x7fffu + ((u >> 16) & 1u)) >> 16; }
__device__ __forceinline__ unsigned pk2(float lo, float hi) { return f2bf(lo) | (f2bf(hi) << 16); }
__device__ __forceinline__ float bflo(unsigned w) { return __builtin_bit_cast(float, w << 16); }
__device__ __forceinline__ float bfhi(unsigned w) { return __builtin_bit_cast(float, w & 0xffff0000u); }
__device__ __forceinline__ float bf2f(bf16 b) { return __builtin_bit_cast(float, ((unsigned)b) << 16); }
__device__ __forceinline__ unsigned cvt_pk_bf16(float lo, float hi) { unsigned r; asm volatile("v_cvt_pk_bf16_f32 %0, %1, %2" : "=v"(r) : "v"(lo), "v"(hi)); return r; }
__device__ __forceinline__ unsigned pk4_fp8(float a, float b, float c, float d) {
    a = __builtin_amdgcn_fmed3f(a, -448.f, 448.f); b = __builtin_amdgcn_fmed3f(b, -448.f, 448.f); c = __builtin_amdgcn_fmed3f(c, -448.f, 448.f); d = __builtin_amdgcn_fmed3f(d, -448.f, 448.f);
    int r = __builtin_amdgcn_cvt_pk_fp8_f32(a, b, 0, false); r = __builtin_amdgcn_cvt_pk_fp8_f32(c, d, r, true); return (unsigned)r; }
__device__ __forceinline__ float fast_exp(float x) { return __builtin_amdgcn_exp2f(x * 1.44269504089f); }
__device__ __forceinline__ float sigmoidf_(float x) { return __builtin_amdgcn_rcpf(1.0f + fast_exp(-x)); }
__device__ __forceinline__ int lane_id() { int l; asm volatile("v_mbcnt_lo_u32_b32 %0, -1, 0\n\tv_mbcnt_hi_u32_b32 %0, -1, %0" : "=v"(l)); return l; }
__device__ __forceinline__ const char* uniform_ptr(const char* p) {
    const unsigned long long v = (unsigned long long)p; const unsigned lo = (unsigned)__builtin_amdgcn_readfirstlane((int)(unsigned)v), hi = (unsigned)__builtin_amdgcn_readfirstlane((int)(unsigned)(v >> 32));
    return (const char*)(((unsigned long long)hi << 32) | lo); }
__device__ __forceinline__ float wave_sum(float v) {
#pragma unroll
    for (int o = 1; o < 64; o <<= 1) v += __shfl_xor(v, o);
    return v;
}

#define XB_TMO      128
#define XB_XCNT(j)  (256  + 64 * (j))
#define XB_XSUB(j)  (1280 + 64 * (j))
#define XB_XGEN(j)  (2304 + 64 * (j))
#define XB_TOP      3328
#define XB_TOPGEN   3392
#define XCD_BAR_WORDS 3456
#define XB_SPIN_CAP (1u << 18)
__device__ __forceinline__ unsigned xb_ld(unsigned* p)              { return __hip_atomic_load(p, __ATOMIC_RELAXED, __HIP_MEMORY_SCOPE_AGENT); }
__device__ __forceinline__ unsigned xb_add(unsigned* p, unsigned v) { return __hip_atomic_fetch_add(p, v, __ATOMIC_RELAXED, __HIP_MEMORY_SCOPE_AGENT); }
__device__ __forceinline__ unsigned xb_xcc_id() { return (unsigned)__builtin_amdgcn_s_getreg((3 << 11) | 20) & 0xFu; }
#define XB_SPIN(cond, bar) do { unsigned _sp = 0; while (cond) { __builtin_amdgcn_s_sleep(1); \
    if ((++_sp & 255u) == 0u) { if (xb_ld(&(bar)[XB_TMO])) break; if (_sp > XB_SPIN_CAP) { atomicAdd(&(bar)[XB_TMO], 1u); break; } } } } while (0)
struct XcdBarrier { unsigned* bar; unsigned x; volatile LAS unsigned* st; unsigned G; };
__device__ __forceinline__ XcdBarrier xcd_barrier_post(unsigned* bar, volatile LAS unsigned* st, bool leader) {
    XcdBarrier b; b.bar = bar; b.x = xb_xcc_id(); b.st = st; b.G = 0u;
    if (leader) (void)xb_add(&bar[XB_XCNT(b.x)], 1u);
    return b;
}
__device__ __forceinline__ void xcd_barrier_complete(unsigned* bar, unsigned x, unsigned& nloc, unsigned& nx, const unsigned G) {
    unsigned sum, cnt, mine, sp = 0u;
    for (;;) {
        sum = 0u; cnt = 0u; mine = 0u;
#pragma unroll
        for (unsigned j = 0; j < 16; ++j) { const unsigned c = xb_ld(&bar[XB_XCNT(j)]); sum += c; cnt += (c > 0u) ? 1u : 0u; mine = (j == x) ? c : mine; }
        if (sum == G) break;
        __builtin_amdgcn_s_sleep(1);
        if ((++sp & 255u) == 0u) { if (xb_ld(&bar[XB_TMO])) break; if (sp > XB_SPIN_CAP) { atomicAdd(&bar[XB_TMO], 1u); break; } }
    }
    nloc = mine > 0u ? mine : 1u; nx = cnt > 0u ? cnt : 1u;
}
__device__ __forceinline__ void xcd_barrier(const XcdBarrier& b, int wave) {
    asm volatile("s_waitcnt vmcnt(0)" ::: "memory");
    __syncthreads();
    if (wave == 0 && lane_id() == 0) {
        unsigned* bar = b.bar;
        __builtin_amdgcn_s_waitcnt(0);
        unsigned nloc = b.st[0], nx = b.st[1];
        if (nloc == 0u) { xcd_barrier_complete(bar, b.x, nloc, nx, b.G); b.st[0] = nloc; b.st[1] = nx; }
        const unsigned old = xb_add(&bar[XB_XSUB(b.x)], 1u);
        const unsigned gen = old / nloc;
        if (old + 1u == (gen + 1u) * nloc) {
            __builtin_amdgcn_fence(__ATOMIC_RELEASE, "agent");
            asm volatile("s_waitcnt vmcnt(0)" ::: "memory");
            const unsigned og = xb_add(&bar[XB_TOP], 1u);
            const unsigned tg = og / nx;
            if (og + 1u == (tg + 1u) * nx) xb_add(&bar[XB_TOPGEN], 1u);
            else XB_SPIN(xb_ld(&bar[XB_TOPGEN]) == tg, bar);
            __builtin_amdgcn_fence(__ATOMIC_ACQUIRE, "agent");
            xb_add(&bar[XB_XGEN(b.x)], 1u);
            asm volatile("s_waitcnt vmcnt(0)" ::: "memory");
        } else {
            XB_SPIN(xb_ld(&bar[XB_XGEN(b.x)]) == gen, bar);
            __builtin_amdgcn_fence(__ATOMIC_ACQUIRE, "agent");
            asm volatile("s_waitcnt vmcnt(0)" ::: "memory");
        }
    }
    __syncthreads();
}


constexpr int CONV_ITEMS = 98304;
constexpr int CONV_ITEMS_PER_WAVE = 1 << 20;
constexpr int CONV_P1_PER_WAVE = 44;
constexpr int CONV_POOL5 = 2048 * CONV_P1_PER_WAVE;
constexpr unsigned CONV_P5_N = 0xB8642100u; constexpr unsigned long long CONV_P5_PRE = 0x150D070301000000ull;
static_assert(CONV_POOL5 + 256 * 32 == CONV_ITEMS, "pool sizes");
struct ConvHook {
    const float* wgu; const float* wd; unsigned char* wguT; unsigned char* wdT; volatile LAS int* cnt; int gw, nw;
    __device__ __forceinline__ void load_item(int it, int lane, f32x4 (&v)[16], unsigned char*& dst) const {
        const int kg = lane >> 3, ng = lane & 7; const float* s; size_t pitch;
        if (it < 65536) { const int e = it >> 11, rr = it & 2047, kb = rr >> 7, nb = rr & 127, n0 = nb * 32, nn = n0 & 2047, drow = (nn >> 7) * 256 + (n0 >= 2048 ? 128 : 0) + (nn & 127);
            s = wgu + (size_t)e * 2048 * 4096 + (size_t)(kb * 128 + kg * 16) * 4096 + n0 + 4 * ng; pitch = 4096;
            dst = wguT + (size_t)e * 4096 * 2048 + (size_t)(drow + 4 * ng) * 2048 + kb * 128 + kg * 16; }
        else { const int i2 = it - 65536, e = i2 >> 10, rr = i2 & 1023, kb = rr >> 6, nb = rr & 63, n0 = nb * 32;
            s = wd + (size_t)e * 2048 * 2048 + (size_t)(kb * 128 + kg * 16) * 2048 + n0 + 4 * ng; pitch = 2048;
            dst = wdT + (size_t)e * 2048 * 2048 + (size_t)(n0 + 4 * ng) * 2048 + kb * 128 + kg * 16; }
#pragma unroll
        for (int i = 0; i < 16; ++i) v[i] = __builtin_nontemporal_load((const f32x4*)(s + (size_t)i * pitch));
    }
    __device__ __forceinline__ void store_item(const f32x4 (&v)[16], unsigned char* dst) const {
#pragma unroll
        for (int c = 0; c < 4; ++c) { u32x4 o;
            o.x = pk4_fp8(v[0][c] * 64.f, v[1][c] * 64.f, v[2][c] * 64.f, v[3][c] * 64.f); o.y = pk4_fp8(v[4][c] * 64.f, v[5][c] * 64.f, v[6][c] * 64.f, v[7][c] * 64.f);
            o.z = pk4_fp8(v[8][c] * 64.f, v[9][c] * 64.f, v[10][c] * 64.f, v[11][c] * 64.f); o.w = pk4_fp8(v[12][c] * 64.f, v[13][c] * 64.f, v[14][c] * 64.f, v[15][c] * 64.f);
            *(u32x4*)(dst + (size_t)c * 2048) = o; }
    }
    template <class IT> __device__ __forceinline__ void run_range(int j, const int jend, int lane, IT item) const {
        if (j >= jend) return;
        f32x4 v0[16], v1[16], v2[16]; unsigned char *d0 = nullptr, *d1 = nullptr, *d2 = nullptr;
        load_item(item(j), lane, v0, d0); if (j + 1 < jend) load_item(item(j + 1), lane, v1, d1); if (j + 2 < jend) load_item(item(j + 2), lane, v2, d2);
        for (; j < jend; j += 3) {
            store_item(v0, d0); if (j + 3 < jend) load_item(item(j + 3), lane, v0, d0);
            if (j + 1 < jend) { store_item(v1, d1); if (j + 4 < jend) load_item(item(j + 4), lane, v1, d1); }
            if (j + 2 < jend) { store_item(v2, d2); if (j + 5 < jend) load_item(item(j + 5), lane, v2, d2); }
        }
    }
    __device__ __forceinline__ void run(int nitems, int lane) const {
        const int j = *cnt; const int jown = (nw == 2048) ? CONV_P1_PER_WAVE : (CONV_ITEMS - gw + nw - 1) / nw; const int jend = (j + nitems < jown) ? j + nitems : jown;
        if (j >= jend) return;
        const int g_ = gw, n_ = nw; run_range(j, jend, lane, [g_, n_](int jj) { return g_ + n_ * jj; });
        *cnt = jend;
    }
};
struct ConvPool {
    ConvHook h; int first, n;
    __device__ __forceinline__ void run(int, int lane) const { const int f_ = first; h.run_range(0, n, lane, [f_](int jj) { return f_ + jj; }); }
};
struct NoHook { __device__ __forceinline__ void run(int, int) const {} };

namespace pg8 {
constexpr int BM = 256, BK = 64, HALF = 128, HTB = HALF * BK * 2, STAGE_BYTES = 8 * HTB, NXCD = 8, WGM = 8;
__host__ __device__ __forceinline__ int lds_byte(int r, int c) { const int st = (r >> 4) * 2 + (c >> 5), rr = r & 15, cc = c & 31, ob = rr * 64 + cc * 2; return st * 1024 + (ob ^ (((ob >> 9) & 1) << 5)); }
__host__ __device__ __forceinline__ void stage_rc(int b, int& R, int& C) { const int st = b / 1024, sb = b % 1024, swz = sb ^ (((sb >> 9) & 1) << 5); R = (st >> 1) * 16 + swz / 64; C = (st & 1) * 32 + (swz % 64) / 2; }
__host__ __device__ __forceinline__ int perm32(int rho) { const int n = rho >> 4, i = rho & 15; return 8 * (i >> 2) + 4 * n + (i & 3); }

struct Unit { const char* a; const char* b; int nt; int pm, pn, z; };
struct Gemm { unsigned lda, ldb; };

__device__ __forceinline__ void tile_order(int L, int nM, int nN, int& pm, int& pn) {
    const int nwg = nM * nN; int wgid = L;
    { const int q = nwg / NXCD, r = nwg % NXCD, xcd = wgid % NXCD, off = wgid / NXCD; wgid = (xcd < r ? xcd * (q + 1) : r * (q + 1) + (xcd - r) * q) + off; }
    const int nig = WGM * nN, gid = wgid / nig, fm = gid * WGM, gsz = (nM - fm) < WGM ? (nM - fm) : WGM;
    pm = fm + ((wgid % nig) % gsz); pn = (wgid % nig) / gsz;
}

template <class Epi, class Sched, class Hook = NoHook, bool FP8 = false, bool ALIGN_EPI = true, bool SP2 = true>
__device__ __forceinline__ void gemm_phase(LAS unsigned char* lds, const int wid, const Gemm g, const Sched& S, const Epi& E, const Hook& H = Hook(), const int hook_rounds = 0, const int hook_slot = -1) {
    const int lane = lane_id(), tid = wid * 64 + lane, wr = wid >> 2, wc = wid & 3;
    unsigned voffA[2], voffB[2];
#pragma unroll
    for (int i = 0; i < 2; ++i) { int R, C; stage_rc(tid * 16 + i * 8192, R, C); const int Rb = Epi::PERM ? ((R & ~31) + perm32(R & 31)) : R;
        voffA[i] = (unsigned)R * g.lda + (unsigned)C * 2u; voffB[i] = (unsigned)Rb * g.ldb + (unsigned)C * 2u; }
    const size_t kstep = (size_t)(BK * 2);
    const size_t hstepA = (size_t)HALF * g.lda, hstepB = (size_t)HALF * g.ldb;
    const unsigned ldsw = (unsigned)wid * 1024u;
    const unsigned ldsbase = (unsigned)(size_t)lds;
    const int aoff = lds_byte(wr * 64 + (lane & 15), (lane >> 4) * 8), boff = lds_byte(wc * 32 + (lane & 15), (lane >> 4) * 8);
#define PG8_SA(b, h) (((b) * 2 + (h)) * HTB)
#define PG8_SB(b, h) ((4 + (b) * 2 + (h)) * HTB)
#define PG8_STAGE(bufoff, gbase, voff) do { unsigned _keep; \
        asm volatile("s_mov_b32 %0, m0\n\ts_mov_b32 m0, %3\n\ts_nop 0\n\tglobal_load_lds_dwordx4 %1, %4\n\ts_bitset1_b32 m0, 13\n\ts_nop 0\n\tglobal_load_lds_dwordx4 %2, %4\n\ts_mov_b32 m0, %0" \
            : "=&s"(_keep) : "v"((voff)[0]), "v"((voff)[1]), "s"(ldsbase + (unsigned)(bufoff) + ldsw), "s"(uniform_ptr((const char*)(gbase))) : "memory"); } while (0)
#define PG8_LDA(dst, b, h) do { _Pragma("unroll") for (int m = 0; m < 4; ++m) _Pragma("unroll") for (int k = 0; k < 2; ++k) dst[m][k] = *(const LAS bf16x8*)(lds + PG8_SA(b, h) + aoff + m * 2048 + k * 1024); } while (0)
#define PG8_LDB(dst, b, h) do { _Pragma("unroll") for (int n = 0; n < 2; ++n) _Pragma("unroll") for (int k = 0; k < 2; ++k) dst[n][k] = *(const LAS bf16x8*)(lds + PG8_SB(b, h) + boff + n * 2048 + k * 1024); } while (0)
#define PG8_MMA(ai, bj, At, Bt) do { __builtin_amdgcn_s_setprio(1); _Pragma("unroll") for (int m = 0; m < 4; ++m) _Pragma("unroll") for (int n = 0; n < 2; ++n) { \
        if constexpr (FP8) { const i32x8 _b8 = __builtin_shufflevector(__builtin_bit_cast(i32x4, Bt[n][0]), __builtin_bit_cast(i32x4, Bt[n][1]), 0, 1, 2, 3, 4, 5, 6, 7); \
                const i32x8 _a8 = __builtin_shufflevector(__builtin_bit_cast(i32x4, At[m][0]), __builtin_bit_cast(i32x4, At[m][1]), 0, 1, 2, 3, 4, 5, 6, 7); \
                asm volatile("v_mfma_scale_f32_16x16x128_f8f6f4 %0, %1, %2, %0, %3, %4 op_sel_hi:[0,0,0]" : "+v"(acc[ai][bj][m][n]) : "v"(_b8), "v"(_a8), "v"(sc_w), "v"(sc_x)); }   \
        else { _Pragma("unroll") for (int k = 0; k < 2; ++k) acc[ai][bj][m][n] = __builtin_amdgcn_mfma_f32_16x16x32_bf16(Bt[n][k], At[m][k], acc[ai][bj][m][n], 0, 0, 0); } } __builtin_amdgcn_s_setprio(0); } while (0)
#define PG8_WAIT_V(n) asm volatile("s_waitcnt vmcnt(" #n ")" ::: "memory")
#define PG8_WAIT_L(n) asm volatile("s_waitcnt lgkmcnt(" #n ")" ::: "memory")
#define PG8_BAR __builtin_amdgcn_s_barrier()
#define PG8_SCHED __builtin_amdgcn_sched_barrier(0)
    const int sc_w = 0x79797979, sc_x = 0x7f7f7f7f; (void)sc_w; (void)sc_x;
    Unit cur, nxt; int ui = 0;
    if (!S.next(0, cur)) return;
    f32x4 acc[2][2][4][2];
#pragma unroll
    for (int a = 0; a < 2; ++a)
#pragma unroll
        for (int b = 0; b < 2; ++b)
#pragma unroll
            for (int m = 0; m < 4; ++m)
#pragma unroll
                for (int n = 0; n < 2; ++n) acc[a][b][m][n] = (f32x4){0.f, 0.f, 0.f, 0.f};
    bf16x8 At[4][2], B0[2][2], B1[2][2];
    const char* cA = cur.a; const char* cB = cur.b;
    S.ready(cur, wid);
    if constexpr (SP2) {
        PG8_STAGE(PG8_SB(0, 0), cB, voffB); PG8_STAGE(PG8_SB(0, 1), cB + hstepB, voffB); PG8_STAGE(PG8_SA(0, 0), cA, voffA); PG8_STAGE(PG8_SA(0, 1), cA + hstepA, voffA);
        if (wr == 1) PG8_BAR;
        PG8_WAIT_V(2); PG8_BAR;
        PG8_STAGE(PG8_SB(1, 0), cB + kstep, voffB); PG8_STAGE(PG8_SA(1, 0), cA + kstep, voffA); PG8_STAGE(PG8_SB(1, 1), cB + hstepB + kstep, voffB);
        PG8_WAIT_V(6); PG8_BAR;
    } else {
        PG8_STAGE(PG8_SB(0, 0), cB, voffB); PG8_STAGE(PG8_SA(0, 0), cA, voffA); PG8_STAGE(PG8_SB(0, 1), cB + hstepB, voffB); PG8_STAGE(PG8_SA(0, 1), cA + hstepA, voffA);
        if (wr == 1) PG8_BAR;
        PG8_WAIT_V(4); PG8_BAR;
        PG8_STAGE(PG8_SB(1, 0), cB + kstep, voffB); PG8_STAGE(PG8_SA(1, 0), cA + kstep, voffA); PG8_STAGE(PG8_SB(1, 1), cB + hstepB + kstep, voffB);
        PG8_WAIT_V(6); PG8_BAR;
    }
    for (;;) {
        const bool has_next = S.next(ui + 1, nxt);
        const char* nA = has_next ? nxt.a : cA; const char* nB = has_next ? nxt.b : cB;
        const int nt = cur.nt;
#pragma unroll 1
        for (int t = 0; t < nt; t += 2) {
            const bool last = (t == nt - 2);
            if (last && has_next) S.ready(nxt, wid);
            const char* a1 = cA + (size_t)(t + 1) * kstep;
            const char* a2 = last ? nA : cA + (size_t)(t + 2) * kstep; const char* b2 = last ? nB : cB + (size_t)(t + 2) * kstep;
            const char* a3 = a2 + kstep; const char* b3 = b2 + kstep;
            if constexpr (SP2) {
            PG8_LDB(B0, 0, 0); PG8_LDB(B1, 0, 1); PG8_SCHED; PG8_LDA(At, 0, 0); PG8_STAGE(PG8_SA(1, 1), a1 + hstepA, voffA);
            PG8_WAIT_V(8); PG8_WAIT_L(0); PG8_BAR; PG8_MMA(0, 0, At, B0); PG8_MMA(0, 1, At, B1); PG8_BAR; PG8_SCHED;
            PG8_LDA(At, 0, 1); PG8_STAGE(PG8_SB(0, 0), b2, voffB); PG8_STAGE(PG8_SB(0, 1), b2 + hstepB, voffB); PG8_STAGE(PG8_SA(0, 0), a2, voffA);
            PG8_WAIT_V(8); PG8_WAIT_L(0); PG8_BAR; PG8_MMA(1, 0, At, B0); PG8_MMA(1, 1, At, B1); PG8_BAR; PG8_SCHED;
            PG8_LDB(B0, 1, 0); PG8_LDB(B1, 1, 1); PG8_SCHED; PG8_LDA(At, 1, 0); PG8_STAGE(PG8_SA(0, 1), a2 + hstepA, voffA);
            PG8_WAIT_V(8); PG8_WAIT_L(0); PG8_BAR; PG8_MMA(0, 0, At, B0); PG8_MMA(0, 1, At, B1); PG8_BAR; PG8_SCHED;
            PG8_LDA(At, 1, 1); PG8_STAGE(PG8_SB(1, 0), b3, voffB); PG8_STAGE(PG8_SB(1, 1), b3 + hstepB, voffB); PG8_STAGE(PG8_SA(1, 0), a3, voffA);
            PG8_WAIT_V(8); PG8_WAIT_L(0); PG8_BAR; PG8_MMA(1, 0, At, B0); PG8_MMA(1, 1, At, B1); PG8_BAR; PG8_SCHED;
            } else {
            PG8_LDB(B0, 0, 0); PG8_SCHED; PG8_LDA(At, 0, 0); PG8_STAGE(PG8_SA(1, 1), a1 + hstepA, voffA);
            PG8_WAIT_L(8); PG8_BAR; PG8_WAIT_L(0); PG8_MMA(0, 0, At, B0); PG8_BAR; PG8_SCHED;
            PG8_LDB(B1, 0, 1); PG8_STAGE(PG8_SB(0, 0), b2, voffB);
            PG8_BAR; PG8_WAIT_L(0); PG8_MMA(0, 1, At, B1); PG8_BAR;
            PG8_LDA(At, 0, 1); PG8_STAGE(PG8_SA(0, 0), a2, voffA);
            PG8_BAR; PG8_WAIT_L(0); PG8_MMA(1, 0, At, B0); PG8_BAR; PG8_SCHED;
            PG8_STAGE(PG8_SB(0, 1), b2 + hstepB, voffB);
            PG8_WAIT_V(6); PG8_BAR; PG8_MMA(1, 1, At, B1); PG8_BAR;
            PG8_LDB(B0, 1, 0); PG8_SCHED; PG8_LDA(At, 1, 0); PG8_STAGE(PG8_SA(0, 1), a2 + hstepA, voffA);
            PG8_WAIT_L(8); PG8_BAR; PG8_WAIT_L(0); PG8_MMA(0, 0, At, B0); PG8_BAR; PG8_SCHED;
            PG8_LDB(B1, 1, 1); PG8_STAGE(PG8_SB(1, 0), b3, voffB);
            PG8_BAR; PG8_WAIT_L(0); PG8_MMA(0, 1, At, B1); PG8_BAR;
            PG8_LDA(At, 1, 1); PG8_STAGE(PG8_SA(1, 0), a3, voffA);
            PG8_BAR; PG8_WAIT_L(0); PG8_MMA(1, 0, At, B0); PG8_BAR; PG8_SCHED;
            PG8_STAGE(PG8_SB(1, 1), b3 + hstepB, voffB);
            PG8_WAIT_V(6); PG8_BAR; PG8_MMA(1, 1, At, B1); PG8_BAR;
            }
        }
        if constexpr (ALIGN_EPI) { if (wr == 0) PG8_BAR; }
        if constexpr (FP8) { asm volatile("s_nop 15\n\ts_nop 15"); }
        const int ln_o = lane_id();
        const bool keep = E(acc, cur, wr, wc, ln_o & 15, ln_o >> 4);
        if (!keep) {
            if (hook_slot == -1 || ui == hook_slot || (hook_slot == -2 && !has_next)) H.run(hook_rounds, ln_o);
#pragma unroll
            for (int a = 0; a < 2; ++a)
#pragma unroll
                for (int b = 0; b < 2; ++b)
#pragma unroll
                    for (int m = 0; m < 4; ++m)
#pragma unroll
                        for (int n = 0; n < 2; ++n) acc[a][b][m][n] = (f32x4){0.f, 0.f, 0.f, 0.f};
        }
        if (!has_next) break;
        cur = nxt; cA = nA; cB = nB; ++ui;
        if constexpr (ALIGN_EPI) { if (wr == 1) PG8_BAR; }
    }
    PG8_WAIT_V(0);
    if constexpr (!ALIGN_EPI) { if (wr == 0) PG8_BAR; }
    PG8_BAR;
#undef PG8_SA
#undef PG8_SB
#undef PG8_STAGE
#undef PG8_LDA
#undef PG8_LDB
#undef PG8_MMA
#undef PG8_WAIT_V
#undef PG8_WAIT_L
#undef PG8_BAR
#undef PG8_SCHED
}

__device__ __forceinline__ f32x2 gelu_pk(f32x2 v) {
    const f32x2 av = __builtin_elementwise_abs(v), d = av * 0.2316418882f + 1.0f;
    f32x2 t; t.x = __builtin_amdgcn_rcpf(d.x); t.y = __builtin_amdgcn_rcpf(d.y);
    f32x2 q = t * 0.5307027145f + (-0.7265760135f); q = q * t + 0.7107068705f; q = q * t + (-0.142248368f); q = q * t + 0.127414796f; q = q * t;
    const f32x2 s = (v * v) * (-0.72134752044f);
    f32x2 e; e.x = __builtin_amdgcn_exp2f(s.x); e.y = __builtin_amdgcn_exp2f(s.y);
    const f32x2 m = v * (q * e), r = v - m;
    f32x2 o; o.x = v.x < 0.f ? m.x : r.x; o.y = v.y < 0.f ? m.y : r.y; return o;
}
}
using pg8::Unit;

struct SchedGrid {
    const char* A; const char* B; unsigned lda, ldb; int nM, nN, G, c, nt, pn_off = 0;
    __device__ __forceinline__ void ready(const Unit&, int) const {}
    __device__ __forceinline__ bool next(int i, Unit& u) const {
        const int L = i * G + c; if (L >= nM * nN) return false;
        int pm, pn; pg8::tile_order(L, nM, nN, pm, pn);
        u.a = A + (size_t)pm * 256 * lda; u.b = B + (size_t)pn * 256 * ldb; u.nt = nt; u.pm = pm; u.pn = pn + pn_off; u.z = 0; return true;
    }
};
struct SchedMerge {
    const char* A; const char* B; int G, c;
    __device__ __forceinline__ void ready(const Unit&, int) const {}
    __device__ __forceinline__ bool next(int i, Unit& u) const {
        const int L = (i >> 1) * G + c, half = i & 1; if (L >= 32 * 8) return false;
        int pm, pn; pg8::tile_order(L, 32, 8, pm, pn);
        u.a = A + (size_t)pm * 256 * 8192 + half * 4096; u.b = B + (size_t)pn * 256 * 8192 + half * 4096; u.nt = 32; u.pm = pm; u.pn = pn; u.z = half; return true;
    }
};
struct SchedSgu {
    const char* Wbd; const char* VgT; int G, c;
    __device__ __forceinline__ void ready(const Unit&, int) const {}
    __device__ __forceinline__ bool next(int i, Unit& u) const {
        const int L = i * G + c; if (L >= 256) return false;
        const int bp = L >> 3, g = L & 7, b = bp >> 3, pair = bp & 7;
        u.a = Wbd + (size_t)g * 256 * 512; u.b = VgT + ((size_t)(b * 2048 + g * 256) * 2048 + pair * 256) * 2; u.nt = 4; u.pm = bp; u.pn = g; u.z = 0; return true;
    }
};
struct SchedQK {
    const char* QKc; int G, c;
    __device__ __forceinline__ void ready(const Unit&, int) const {}
    __device__ __forceinline__ bool next(int i, Unit& u) const {
        int bh, tri;
        if ((G & 7) == 0) { const int x = c & 7, q = c >> 3, W = G >> 3; const int L = i * W + q; if (L >= 72) return false; bh = x + 8 * (L / 36); tri = L % 36; }
        else { const int L = i * G + c; if (L >= 16 * 36) return false; bh = L / 36; tri = L % 36; }
        int pm = 0; while ((pm + 1) * (pm + 2) / 2 <= tri) ++pm; const int pn = tri - pm * (pm + 1) / 2;
        const int b = bh >> 2, h = bh & 3;
        u.a = QKc + ((size_t)(b * 2048 + pm * 256) * 4096 + h * 512) * 2; u.b = QKc + ((size_t)(b * 2048 + pn * 256) * 4096 + 2048 + h * 512) * 2;
        u.nt = 8; u.pm = pm; u.pn = pn; u.z = bh; return true;
    }
};
struct SchedPV {
    const char* P; const char* VmT; int G, c;
    __device__ __forceinline__ void ready(const Unit&, int) const {}
    __device__ __forceinline__ bool next(int i, Unit& u) const {
        const int L = i * G + c; if (L >= 256) return false;
        const int bh = L & 15, r = L >> 4, pm = 7 - (r >> 1), pn = r & 1, b = bh >> 2, h = bh & 3;
        u.a = P + ((size_t)(bh * 2048 + pm * 256) * 2048) * 2; u.b = VmT + ((size_t)(b * 2048 + h * 512 + pn * 256) * 2048) * 2;
        u.nt = 4 * (pm + 1); u.pm = pm; u.pn = pn; u.z = bh; return true;
    }
};
struct SchedMoe {
    const char* A; const char* B; volatile LAS int* tab; int NT; size_t bexp; int G, c;
    __device__ __forceinline__ void ready(const Unit&, int) const {}
    __device__ __forceinline__ bool next(int i, Unit& u) const {
        const int NG = (G & 7) ? 1 : 8, x = c % NG, q = c / NG, W = G / NG, ne = 32 / NG;
        const int L = i * W + q; const int total = __builtin_amdgcn_readfirstlane(tab[ne]); if (L >= total) return false;
        int j = 0; while (L >= __builtin_amdgcn_readfirstlane(tab[j + 1])) ++j;
        const int e = x + NG * j, r = L - __builtin_amdgcn_readfirstlane(tab[j]), tiles = __builtin_amdgcn_readfirstlane(tab[40 + j]);
        const int ti = r % tiles, pn = r / tiles;
        u.a = A + ((size_t)e * CAP + (size_t)ti * 256) * 2048; u.b = B + (size_t)e * bexp + (size_t)pn * 256 * 2048; u.nt = 16; u.pm = ti; u.pn = pn; u.z = e; return true;
    }
};

struct SchedMoe2 {
    const char *Xs, *Ha, *Wgu, *Wd; volatile LAS int* tab; int G, c; unsigned* hcnt; unsigned* tmo; int kind;
    __device__ __forceinline__ bool next(int i, Unit& u) const {
        const int NG = (G & 7) ? 1 : 8, q = c / NG, W = G / NG, ne = 32 / NG;
        const int t10 = __builtin_amdgcn_readfirstlane(tab[ne]); const int n1 = (t10 > q) ? (t10 - q + W - 1) / W : 0;
        const int L = (kind == 0) ? i * W + q : (i + n1) * W + q; if (kind == 0 && L >= t10) return false;
        if (L < t10) { int j = 0; while (L >= __builtin_amdgcn_readfirstlane(tab[j + 1])) ++j;
            const int e = __builtin_amdgcn_readfirstlane(tab[(NG == 8 ? 48 : 80) + j]), r = L - __builtin_amdgcn_readfirstlane(tab[j]), tiles = __builtin_amdgcn_readfirstlane(tab[40 + j]); const int ti = r % tiles, pn = r / tiles;
            u.a = uniform_ptr(Xs + ((size_t)e * CAP + (size_t)ti * 256) * 2048); u.b = uniform_ptr(Wgu + (size_t)e * ((size_t)4096 * 2048) + (size_t)pn * 256 * 2048); u.nt = 16; u.pm = ti; u.pn = pn; u.z = e; return true; }
        const int L2 = L - t10; if (L2 >= (t10 >> 1)) return false;
        int j = 0; while (L2 >= (__builtin_amdgcn_readfirstlane(tab[j + 1]) >> 1)) ++j;
        const int e = __builtin_amdgcn_readfirstlane(tab[(NG == 8 ? 48 : 80) + j]), r = L2 - (__builtin_amdgcn_readfirstlane(tab[j]) >> 1), tiles = __builtin_amdgcn_readfirstlane(tab[40 + j]); const int ti = r % tiles, pn = r / tiles;
        u.a = uniform_ptr(Ha + ((size_t)e * CAP + (size_t)ti * 256) * 2048); u.b = uniform_ptr(Wd + (size_t)e * ((size_t)2048 * 2048) + (size_t)pn * 256 * 2048); u.nt = 16; u.pm = ti; u.pn = pn; u.z = e + 32; return true;
    }
    __device__ __forceinline__ void ready(const Unit& u, int wid) const {
        if (u.z < 32 || hcnt == nullptr) return;
        if (wid == 0) { unsigned* cp = hcnt + (size_t)((u.z - 32) * 32 + u.pm) * 16; unsigned spins = 0;
            while ((unsigned)__builtin_amdgcn_readfirstlane((int)__hip_atomic_load(cp, __ATOMIC_RELAXED, __HIP_MEMORY_SCOPE_AGENT)) < 128u) {
                if ((++spins & 63u) == 0u && __builtin_amdgcn_readfirstlane((int)__hip_atomic_load(tmo, __ATOMIC_RELAXED, __HIP_MEMORY_SCOPE_AGENT)) != 0) break;
                if (spins > (1u << 20)) { __hip_atomic_store(tmo, 1u, __ATOMIC_RELAXED, __HIP_MEMORY_SCOPE_AGENT); break; }
                __builtin_amdgcn_s_sleep(2); }
            __builtin_amdgcn_fence(__ATOMIC_ACQUIRE, "agent");
            asm volatile("s_waitcnt vmcnt(0)" ::: "memory"); }
        asm volatile("" ::: "memory"); __builtin_amdgcn_s_barrier(); asm volatile("" ::: "memory");
    }
};

using pg8::gelu_pk;
#define EPI_ARGS f32x4 (&acc)[2][2][4][2], const Unit& u, int wr, int wc, int fr, int fq
struct EpiIn {
    static constexpr bool PERM = true;
    const float* b_in; unsigned char* wsb;
    __device__ __forceinline__ bool operator()(EPI_ARGS) const {
        GAS unsigned char* w_ = (GAS unsigned char*)wsb; asm volatile("" : "+s"(w_));
        bf16* const Ug = (bf16*)(GAS bf16*)(w_ + WS_UG); bf16* const VgT = (bf16*)(GAS bf16*)(w_ + WS_VGT); bf16* const QKr = (bf16*)(GAS bf16*)(w_ + WS_QKR); bf16* const VmT = (bf16*)(GAS bf16*)(w_ + WS_VMT);
        bf16* const Og = (bf16*)(GAS bf16*)(w_ + WS_OG); bf16* const Ga = (bf16*)(GAS bf16*)(w_ + WS_GA); float* const vpart = (float*)(GAS float*)(w_ + WS_VPART);
        const int pn = u.pn; const int row0 = u.pm * 256 + wr * 64 + fr; const int cw = wc * 32 + 8 * fq;
        const int ncol0 = pn * 256 + cw; const int bcol0 = ncol0 + (ncol0 >= 12288 ? 8 : 0);
        f32x4 bv[2][2];
#pragma unroll
        for (int bj = 0; bj < 2; ++bj)
#pragma unroll
            for (int n = 0; n < 2; ++n) {
                const float* bp = b_in + bcol0 + bj * 128 + 4 * n; bv[bj][n] = (f32x4){bp[0], bp[1], bp[2], bp[3]}; }
        __builtin_amdgcn_s_waitcnt(0x0F70);
        if (pn < 8 || (pn >= 16 && pn < 32) || pn >= 40) {
            bf16* base; int ldc, colt; int act;
            if (pn < 8) { base = Ug; ldc = 2048; colt = pn * 256; act = 1; }
            else if (pn < 32) { base = QKr; ldc = 4096; colt = (pn - 16) * 256; act = 0; }
            else if (pn < 48) { base = Og; ldc = 2048; colt = (pn - 40) * 256; act = 2; }
            else { base = Ga; ldc = 2048; colt = (pn - 48) * 256; act = 2; if (pn >= 56) { base += (size_t)T * 2048; colt -= 2048; } }
#pragma unroll
            for (int ai = 0; ai < 2; ++ai)
#pragma unroll
                for (int m = 0; m < 4; ++m) { bf16* rowp = base + (size_t)(row0 + ai * 128 + m * 16) * ldc + colt + cw;
#pragma unroll
                    for (int bj = 0; bj < 2; ++bj) { f32x4 v0 = acc[ai][bj][m][0] + bv[bj][0], v1 = acc[ai][bj][m][1] + bv[bj][1];
                        if (act == 1) { f32x2 a = gelu_pk((f32x2){v0[0], v0[1]}), b = gelu_pk((f32x2){v0[2], v0[3]}), c = gelu_pk((f32x2){v1[0], v1[1]}), d = gelu_pk((f32x2){v1[2], v1[3]});
                            v0 = (f32x4){a.x, a.y, b.x, b.y}; v1 = (f32x4){c.x, c.y, d.x, d.y}; }
                        else if (act == 2) {
#pragma unroll
                            for (int j = 0; j < 4; ++j) { v0[j] = sigmoidf_(v0[j]); v1[j] = sigmoidf_(v1[j]); } }
                        u32x4 w; w.x = cvt_pk_bf16(v0[0], v0[1]); w.y = cvt_pk_bf16(v0[2], v0[3]); w.z = cvt_pk_bf16(v1[0], v1[1]); w.w = cvt_pk_bf16(v1[2], v1[3]);
                        *(u32x4*)(rowp + bj * 128) = w; } }
        } else {
            const bool isv = pn < 16; bf16* base = isv ? VgT : VmT; const int colt = (isv ? pn - 8 : pn - 32) * 256;
#pragma unroll
            for (int ai = 0; ai < 2; ++ai)
#pragma unroll
                for (int m = 0; m < 4; ++m) { const int row = row0 + ai * 128 + m * 16; const int b = row >> 11, s = row & 2047; float sm = 0.f, sq = 0.f;
#pragma unroll
                    for (int bj = 0; bj < 2; ++bj) { f32x4 v0 = acc[ai][bj][m][0] + bv[bj][0], v1 = acc[ai][bj][m][1] + bv[bj][1];
                        if (isv) { f32x2 a = gelu_pk((f32x2){v0[0], v0[1]}), bb = gelu_pk((f32x2){v0[2], v0[3]}), c = gelu_pk((f32x2){v1[0], v1[1]}), d = gelu_pk((f32x2){v1[2], v1[3]});
                            v0 = (f32x4){a.x, a.y, bb.x, bb.y}; v1 = (f32x4){c.x, c.y, d.x, d.y};
#pragma unroll
                            for (int j = 0; j < 4; ++j) { sm += v0[j] + v1[j]; sq += v0[j] * v0[j] + v1[j] * v1[j]; } }
                        bf16* cp = base + ((size_t)(b * 2048 + colt + bj * 128 + cw) * 2048 + s);
#pragma unroll
                        for (int j = 0; j < 4; ++j) { cp[(size_t)j * 2048] = (bf16)f2bf(v0[j]); cp[(size_t)(4 + j) * 2048] = (bf16)f2bf(v1[j]); } }
                    if (isv) { sm += __shfl_xor(sm, 16); sm += __shfl_xor(sm, 32); sq += __shfl_xor(sq, 16); sq += __shfl_xor(sq, 32);
                        if (fq == 0) { float* vp = vpart + (size_t)row * 64 + (pn - 8) * 4 + wc; vp[0] = sm; vp[32] = sq; } } }
        }
        return false;
    }
};
struct EpiSgu {
    static constexpr bool PERM = true;
    const bf16* Ug; const float* b_sgu; bf16* Y;
    __device__ __forceinline__ bool operator()(EPI_ARGS) const {
        const int g = u.pn; const int rt0 = wr * 64 + fr; const int cw = wc * 32 + 8 * fq;
#pragma unroll
        for (int ai = 0; ai < 2; ++ai) {
            u32x4 uu[4][2]; float bs[4];
#pragma unroll
            for (int m = 0; m < 4; ++m) { const int rt = rt0 + ai * 128 + m * 16; const size_t row = (size_t)u.pm * 256 + rt; bs[m] = b_sgu[g * 128 + (rt & 127)];
#pragma unroll
                for (int bj = 0; bj < 2; ++bj) uu[m][bj] = *(const u32x4*)(Ug + row * 2048 + g * 256 + bj * 128 + cw); }
#pragma unroll
            for (int m = 0; m < 4; ++m) { const int rt = rt0 + ai * 128 + m * 16; const size_t row = (size_t)u.pm * 256 + rt;
#pragma unroll
                for (int bj = 0; bj < 2; ++bj) { const int col = g * 256 + bj * 128 + cw; const u32x4 q = uu[m][bj];
                    const f32x4 v0 = acc[ai][bj][m][0] + bs[m], v1 = acc[ai][bj][m][1] + bs[m];
                    u32x4 w; w.x = cvt_pk_bf16(bflo(q.x) * v0[0], bfhi(q.x) * v0[1]); w.y = cvt_pk_bf16(bflo(q.y) * v0[2], bfhi(q.y) * v0[3]);
                    w.z = cvt_pk_bf16(bflo(q.z) * v1[0], bfhi(q.z) * v1[1]); w.w = cvt_pk_bf16(bflo(q.w) * v1[2], bfhi(q.w) * v1[3]);
                    *(u32x4*)(Y + row * 4096 + col) = w; } }
            asm volatile("" ::: "memory"); }
        return false;
    }
};
struct EpiQK {
    static constexpr bool PERM = true;
    const float *aS, *Mt; bf16* P; float* denp;
    __device__ __forceinline__ bool operator()(EPI_ARGS) const {
        const int bh = u.z; const int cw = wc * 32 + 8 * fq; const bool diag = (u.pm == u.pn);
        float av[2][8];
#pragma unroll
        for (int bj = 0; bj < 2; ++bj) { const float* ap = aS + bh * 2048 + u.pn * 256 + bj * 128 + cw;
#pragma unroll
            for (int j = 0; j < 8; ++j) av[bj][j] = ap[j] * 1.44269504089f; }
        const int rt0 = wr * 64 + fr;
        const float* mtp = Mt + bh * 2048 + u.pm * 256 + rt0; float* dpp = denp + (size_t)(bh * 2048 + u.pm * 256 + rt0) * 32 + u.pn * 4 + wc;
        bf16* prow = P + ((size_t)(bh * 2048 + u.pm * 256 + rt0) * 2048 + u.pn * 256 + cw);
        float mtv[8];
#pragma unroll
        for (int r8 = 0; r8 < 8; ++r8) mtv[r8] = mtp[(r8 >> 2) * 128 + (r8 & 3) * 16] * 1.44269504089f;
#pragma unroll
        for (int ai = 0; ai < 2; ++ai)
#pragma unroll
            for (int m = 0; m < 4; ++m) { const int ro = ai * 128 + m * 16; const float mt = mtv[ai * 4 + m]; float rs = 0.f;
#pragma unroll
                for (int bj = 0; bj < 2; ++bj) { float o[8];
                    const float lim = diag ? (float)(rt0 + ro - bj * 128 - cw + 1) : 1.0e9f;
#pragma unroll
                    for (int j = 0; j < 8; ++j) { const float sv = (j < 4) ? acc[ai][bj][m][0][j] : acc[ai][bj][m][1][j - 4];
                        const float w = __builtin_amdgcn_exp2f(fminf(av[bj][j] - mt, 0.f)); const float f = __builtin_amdgcn_fmed3f(lim - (float)j, 0.f, 1.f);
                        o[j] = sv * (w * f); rs += o[j]; }
                    u32x4 w4; w4.x = cvt_pk_bf16(o[0], o[1]); w4.y = cvt_pk_bf16(o[2], o[3]); w4.z = cvt_pk_bf16(o[4], o[5]); w4.w = cvt_pk_bf16(o[6], o[7]);
                    *(u32x4*)(prow + (size_t)ro * 2048 + bj * 128) = w4; }
                rs += __shfl_xor(rs, 16); rs += __shfl_xor(rs, 32);
                if (fq == 0) dpp[(size_t)ro * 32] = rs;
                asm volatile("" ::: "memory"); }
        return false;
    }
};
struct EpiPV {
    static constexpr bool PERM = true;
    const float *denp, *Bm; bf16* Hm; float* ssqp;
    __device__ __forceinline__ bool operator()(EPI_ARGS) const {
        const int bh = u.z, b = bh >> 2, h = bh & 3; const int cw = wc * 32 + 8 * fq; const int t0 = u.pm * 256 + wr * 64 + fr;
        float dsum[8], bm[8];
#pragma unroll
        for (int r8 = 0; r8 < 8; ++r8) { dsum[r8] = 0.f; bm[r8] = Bm[bh * 2048 + t0 + (r8 >> 2) * 128 + (r8 & 3) * 16]; }
#pragma unroll 2
        for (int q = 0; q <= u.pm; ++q) { f32x4 d4[8];
#pragma unroll
            for (int r8 = 0; r8 < 8; ++r8) d4[r8] = *(const f32x4*)(denp + (size_t)(bh * 2048 + t0 + (r8 >> 2) * 128 + (r8 & 3) * 16) * 32 + q * 4);
#pragma unroll
            for (int r8 = 0; r8 < 8; ++r8) dsum[r8] += (d4[r8].x + d4[r8].y) + (d4[r8].z + d4[r8].w); }
#pragma unroll
        for (int ai = 0; ai < 2; ++ai)
#pragma unroll
            for (int m = 0; m < 4; ++m) { const int t = t0 + ai * 128 + m * 16; const int tok = b * 2048 + t;
                const float dn = fabsf(dsum[ai * 4 + m]), lo = fast_exp(-bm[ai * 4 + m]); const float inv = 1.0f / fmaxf(dn, lo); float sq = 0.f;
#pragma unroll
                for (int bj = 0; bj < 2; ++bj) { const f32x4 v0 = acc[ai][bj][m][0] * inv, v1 = acc[ai][bj][m][1] * inv;
#pragma unroll
                    for (int j = 0; j < 4; ++j) sq += v0[j] * v0[j] + v1[j] * v1[j];
                    u32x4 w; w.x = cvt_pk_bf16(v0[0], v0[1]); w.y = cvt_pk_bf16(v0[2], v0[3]); w.z = cvt_pk_bf16(v1[0], v1[1]); w.w = cvt_pk_bf16(v1[2], v1[3]);
                    *(u32x4*)(Hm + (size_t)tok * 2048 + h * 512 + u.pn * 256 + bj * 128 + cw) = w; }
                sq += __shfl_xor(sq, 16); sq += __shfl_xor(sq, 32);
                if (fq == 0) ssqp[(size_t)(tok * 4 + h) * 8 + u.pn * 4 + wc] = sq; }
        return false;
    }
};
struct EpiMerge {
    static constexpr bool PERM = true;
    const bf16 *Ga, *Gm; bf16* Mrg;
    __device__ __forceinline__ bool operator()(EPI_ARGS) const {
        const int cw = wc * 32 + 8 * fq; const bool first = (u.z == 0);
#pragma unroll
        for (int ai = 0; ai < 2; ++ai) {
            u32x4 gmv[4][2], gav[4][2];
#pragma unroll
            for (int m = 0; m < 4; ++m) { const size_t row = (size_t)u.pm * 256 + wr * 64 + fr + ai * 128 + m * 16;
#pragma unroll
                for (int bj = 0; bj < 2; ++bj) { const size_t off = row * 2048 + u.pn * 256 + bj * 128 + cw;
                    gmv[m][bj] = *(const u32x4*)(Gm + off); if (first) gav[m][bj] = *(const u32x4*)(Ga + off); else gav[m][bj] = (u32x4){0u, 0u, 0u, 0u}; } }
#pragma unroll
            for (int m = 0; m < 4; ++m) { const size_t row = (size_t)u.pm * 256 + wr * 64 + fr + ai * 128 + m * 16;
#pragma unroll
                for (int bj = 0; bj < 2; ++bj) { const size_t off = row * 2048 + u.pn * 256 + bj * 128 + cw;
                    const u32x4 gm = gmv[m][bj];
                    float s[8] = {bflo(gm.x), bfhi(gm.x), bflo(gm.y), bfhi(gm.y), bflo(gm.z), bfhi(gm.z), bflo(gm.w), bfhi(gm.w)};
                    if (first) { const u32x4 ga = gav[m][bj];
                        const float a[8] = {bflo(ga.x), bfhi(ga.x), bflo(ga.y), bfhi(ga.y), bflo(ga.z), bfhi(ga.z), bflo(ga.w), bfhi(ga.w)};
#pragma unroll
                        for (int j = 0; j < 4; ++j) { acc[ai][bj][m][0][j] *= a[j] / fmaxf(s[j], 1e-30f); acc[ai][bj][m][1][j] *= a[4 + j] / fmaxf(s[4 + j], 1e-30f); }
                    } else { const f32x4 v0 = acc[ai][bj][m][0], v1 = acc[ai][bj][m][1];
                        u32x4 w; w.x = cvt_pk_bf16(v0[0] * s[0], v0[1] * s[1]); w.y = cvt_pk_bf16(v0[2] * s[2], v0[3] * s[3]); w.z = cvt_pk_bf16(v1[0] * s[4], v1[1] * s[5]); w.w = cvt_pk_bf16(v1[2] * s[6], v1[3] * s[7]);
                        *(u32x4*)(Mrg + off) = w; } } }
            asm volatile("" ::: "memory"); }
        return first;
    }
};
struct EpiX1 {
    static constexpr bool PERM = false;
    const float* x; float* x1;
    __device__ __forceinline__ bool operator()(EPI_ARGS) const {
        const int row0 = u.pm * 256 + wr * 64 + fr, col0 = u.pn * 256 + wc * 32 + 4 * fq;
#pragma unroll
        for (int ai = 0; ai < 2; ++ai)
#pragma unroll
            for (int m = 0; m < 4; ++m) { const size_t off = (size_t)(row0 + ai * 128 + m * 16) * 2048 + col0;
#pragma unroll
                for (int bj = 0; bj < 2; ++bj)
#pragma unroll
                    for (int n = 0; n < 2; ++n) { const f32x4 xv = *(const f32x4*)(x + off + bj * 128 + n * 16); *(f32x4*)(x1 + off + bj * 128 + n * 16) = xv + acc[ai][bj][m][n]; } }
        return false;
    }
};
struct EpiGU {
    static constexpr bool PERM = true;
    const float* b_gu; unsigned char* Ha;
    __device__ __forceinline__ bool operator()(EPI_ARGS) const {
        const int e = u.z & 31; const int cw = wc * 32 + 8 * fq; const float* bg = b_gu + (size_t)e * 4096 + u.pn * 128 + cw;
        float bgv[8], buv[8];
#pragma unroll
        for (int j = 0; j < 8; ++j) { bgv[j] = bg[j]; buv[j] = bg[2048 + j]; }
#pragma unroll
        for (int ai = 0; ai < 2; ++ai)
#pragma unroll
            for (int m = 0; m < 4; ++m) { const size_t row = (size_t)e * CAP + (size_t)u.pm * 256 + wr * 64 + fr + ai * 128 + m * 16; float o[8];
#pragma unroll
                for (int j = 0; j < 8; ++j) { float gt = ((j < 4) ? acc[ai][0][m][0][j] : acc[ai][0][m][1][j - 4]) + bgv[j]; float up = ((j < 4) ? acc[ai][1][m][0][j] : acc[ai][1][m][1][j - 4]) + buv[j];
                    gt = fminf(gt, 7.0f); up = fminf(fmaxf(up, -7.0f), 7.0f);
                    o[j] = (up + 1.0f) * (gt * sigmoidf_(1.702f * gt)); }
                u32x2 w; w.x = pk4_fp8(o[0], o[1], o[2], o[3]); w.y = pk4_fp8(o[4], o[5], o[6], o[7]);
                *(u32x2*)(Ha + row * 2048 + u.pn * 128 + cw) = w; }
        return false;
    }
};
struct EpiDown {
    static constexpr bool PERM = true;
    const float* b_d; bf16* Ye;
    __device__ __forceinline__ bool operator()(EPI_ARGS) const {
        const int e = u.z & 31; const int cw = wc * 32 + 8 * fq;
        f32x4 bv[2][2];
#pragma unroll
        for (int bj = 0; bj < 2; ++bj)
#pragma unroll
            for (int n = 0; n < 2; ++n) bv[bj][n] = *(const f32x4*)(b_d + (size_t)e * 2048 + u.pn * 256 + bj * 128 + cw + 4 * n);
#pragma unroll
        for (int ai = 0; ai < 2; ++ai)
#pragma unroll
            for (int m = 0; m < 4; ++m) { const size_t row = (size_t)e * CAP + (size_t)u.pm * 256 + wr * 64 + fr + ai * 128 + m * 16;
#pragma unroll
                for (int bj = 0; bj < 2; ++bj) { const f32x4 v0 = acc[ai][bj][m][0] + bv[bj][0], v1 = acc[ai][bj][m][1] + bv[bj][1];
                    u32x4 w; w.x = cvt_pk_bf16(v0[0], v0[1]); w.y = cvt_pk_bf16(v0[2], v0[3]); w.z = cvt_pk_bf16(v1[0], v1[1]); w.w = cvt_pk_bf16(v1[2], v1[3]);
                    *(u32x4*)(Ye + row * 2048 + u.pn * 256 + bj * 128 + cw) = w; } }
        return false;
    }
};

struct EpiGUc {
    static constexpr bool PERM = true;
    const float* b_gu; unsigned char* Ha; unsigned* hcnt; mutable int pend;
    __device__ __forceinline__ void flush(int lane) const { if (pend >= 0 && lane == 0) __hip_atomic_fetch_add(hcnt + (size_t)pend * 16, 1u, __ATOMIC_RELAXED, __HIP_MEMORY_SCOPE_AGENT); pend = -1; }
    __device__ __forceinline__ bool operator()(EPI_ARGS) const {
        flush(fr + 16 * fq);
        const int e = u.z & 31; const int cw = wc * 32 + 8 * fq;
        const float* bg = b_gu + (size_t)e * 4096 + u.pn * 128 + cw; const f32x4 g0 = *(const f32x4*)bg, g1 = *(const f32x4*)(bg + 4), u0 = *(const f32x4*)(bg + 2048), u1 = *(const f32x4*)(bg + 2052);
        const float bgv[8] = {g0.x, g0.y, g0.z, g0.w, g1.x, g1.y, g1.z, g1.w}, buv[8] = {u0.x, u0.y, u0.z, u0.w, u1.x, u1.y, u1.z, u1.w};
#pragma unroll
        for (int ai = 0; ai < 2; ++ai)
#pragma unroll
            for (int m = 0; m < 4; ++m) { const size_t row = (size_t)e * CAP + (size_t)u.pm * 256 + wr * 64 + fr + ai * 128 + m * 16; float o[8];
#pragma unroll
                for (int j = 0; j < 8; ++j) { float gt = ((j < 4) ? acc[ai][0][m][0][j] : acc[ai][0][m][1][j - 4]) + bgv[j]; float up = ((j < 4) ? acc[ai][1][m][0][j] : acc[ai][1][m][1][j - 4]) + buv[j];
                    gt = fminf(gt, 7.0f); up = fminf(fmaxf(up, -7.0f), 7.0f);
                    o[j] = (up + 1.0f) * (gt * sigmoidf_(1.702f * gt)); }
                const unsigned long long w = (unsigned long long)pk4_fp8(o[0], o[1], o[2], o[3]) | ((unsigned long long)pk4_fp8(o[4], o[5], o[6], o[7]) << 32);
                __hip_atomic_store((unsigned long long*)(Ha + row * 2048 + u.pn * 128 + cw), w, __ATOMIC_RELAXED, __HIP_MEMORY_SCOPE_AGENT); }
        pend = e * 32 + u.pm;
        return false;
    }
};

struct Args { const float* in[22]; float* out; unsigned char* ws; int ph_lo, ph_hi, li, pad; };
struct Frame {
    LAS unsigned char* lds; int wave, G, bx;
    unsigned char* ws;
};
template <int OFF> __device__ __forceinline__ unsigned long long karg_u64() {
    auto kp = __builtin_amdgcn_kernarg_segment_ptr();
    unsigned long long v;
    asm volatile("s_load_dwordx2 %0, %1, %2\n\ts_waitcnt lgkmcnt(0)" : "=s"(v) : "s"(kp), "i"(OFF));
    return v;
}
#define INP(i) ((const float*)(const GAS float*)karg_u64<8 * (i)>())
#define OUTP() ((float*)(GAS float*)karg_u64<176>())
#define WSP() ((unsigned char*)(GAS unsigned char*)karg_u64<184>())

__device__ __forceinline__ void transpose_item(const float* src, size_t spitch, int k0, int n0, bf16* dst, size_t dpitch, int drow0, int dk0, LAS float* scr, int lane) {
#pragma unroll 8
    for (int i = 0; i < 32; ++i) { const int kk = 2 * i + (lane >> 5); scr[kk * 33 + (lane & 31)] = src[(size_t)(k0 + kk) * spitch + n0 + (lane & 31)]; }
    LDS_WAIT(); asm volatile("" ::: "memory");
    const int c = lane & 7;
#pragma unroll
    for (int j = 0; j < 4; ++j) { const int n = (lane >> 3) + 8 * j; const LAS float* s = scr + (8 * c) * 33 + n;
        u32x4 o; o.x = pk2(s[0 * 33], s[1 * 33]); o.y = pk2(s[2 * 33], s[3 * 33]); o.z = pk2(s[4 * 33], s[5 * 33]); o.w = pk2(s[6 * 33], s[7 * 33]);
        *(u32x4*)(dst + (size_t)(drow0 + n) * dpitch + dk0 + 8 * c) = o; }
    LDS_WAIT(); asm volatile("" ::: "memory");
}

__device__ __forceinline__ void transpose_item_fp8(const float* src, size_t spitch, int k0, int n0, unsigned char* dst, size_t dpitch, int drow0, int dk0, LAS float* scr, int lane) {
#pragma unroll 8
    for (int i = 0; i < 32; ++i) { const int kk = 2 * i + (lane >> 5); scr[kk * 33 + (lane & 31)] = src[(size_t)(k0 + kk) * spitch + n0 + (lane & 31)]; }
    LDS_WAIT(); asm volatile("" ::: "memory");
    const int c = lane & 3;
#pragma unroll
    for (int j = 0; j < 2; ++j) { const int n = (lane >> 2) + 16 * j; const LAS float* s = scr + (16 * c) * 33 + n;
        u32x4 o; o.x = pk4_fp8(s[0 * 33] * 64.f, s[1 * 33] * 64.f, s[2 * 33] * 64.f, s[3 * 33] * 64.f); o.y = pk4_fp8(s[4 * 33] * 64.f, s[5 * 33] * 64.f, s[6 * 33] * 64.f, s[7 * 33] * 64.f);
        o.z = pk4_fp8(s[8 * 33] * 64.f, s[9 * 33] * 64.f, s[10 * 33] * 64.f, s[11 * 33] * 64.f); o.w = pk4_fp8(s[12 * 33] * 64.f, s[13 * 33] * 64.f, s[14 * 33] * 64.f, s[15 * 33] * 64.f);
        *(u32x4*)(dst + (size_t)(drow0 + n) * dpitch + dk0 + 16 * c) = o; }
    LDS_WAIT(); asm volatile("" ::: "memory");
}

__device__ __forceinline__ void conv_item_bf16(const float* src, size_t spitch, int k0, int n0, bf16* dst, size_t dpitch, int drow0, int dk0, int lane) {
    const int kg = lane >> 3, ng = lane & 7; const float* s = src + (size_t)(k0 + kg * 16) * spitch + n0 + 4 * ng; f32x4 v[16];
#pragma unroll
    for (int i = 0; i < 16; ++i) v[i] = __builtin_nontemporal_load((const f32x4*)(s + (size_t)i * spitch));
    bf16* d = dst + (size_t)(drow0 + 4 * ng) * dpitch + dk0 + kg * 16;
#pragma unroll
    for (int c = 0; c < 4; ++c) { u32x4 o0, o1;
        o0.x = pk2(v[0][c], v[1][c]); o0.y = pk2(v[2][c], v[3][c]); o0.z = pk2(v[4][c], v[5][c]); o0.w = pk2(v[6][c], v[7][c]);
        o1.x = pk2(v[8][c], v[9][c]); o1.y = pk2(v[10][c], v[11][c]); o1.z = pk2(v[12][c], v[13][c]); o1.w = pk2(v[14][c], v[15][c]);
        *(u32x4*)(d + (size_t)c * dpitch) = o0; *(u32x4*)(d + (size_t)c * dpitch + 8) = o1; }
}

__device__ __forceinline__ void conv_item_fp8(const float* src, size_t spitch, int k0, int n0, unsigned char* dst, size_t dpitch, int drow0, int dk0, int lane) {
    const int kg = lane >> 3, ng = lane & 7; const float* s = src + (size_t)(k0 + kg * 16) * spitch + n0 + 4 * ng; f32x4 v[16];
#pragma unroll
    for (int i = 0; i < 16; ++i) v[i] = __builtin_nontemporal_load((const f32x4*)(s + (size_t)i * spitch));
    unsigned char* d = dst + (size_t)(drow0 + 4 * ng) * dpitch + dk0 + kg * 16;
#pragma unroll
    for (int c = 0; c < 4; ++c) { u32x4 o;
        o.x = pk4_fp8(v[0][c] * 64.f, v[1][c] * 64.f, v[2][c] * 64.f, v[3][c] * 64.f); o.y = pk4_fp8(v[4][c] * 64.f, v[5][c] * 64.f, v[6][c] * 64.f, v[7][c] * 64.f);
        o.z = pk4_fp8(v[8][c] * 64.f, v[9][c] * 64.f, v[10][c] * 64.f, v[11][c] * 64.f); o.w = pk4_fp8(v[12][c] * 64.f, v[13][c] * 64.f, v[14][c] * 64.f, v[15][c] * 64.f);
        *(u32x4*)(d + (size_t)c * dpitch) = o; }
}

struct ConvPoolB {
    const float *pa, *pm, *wo; bf16 *pam, *wout; int first, n;
    __device__ __forceinline__ void run(int, int lane) const {
        for (int jj = 0; jj < n; ++jj) { int r = first + jj;
            if (r < 1024) { const int kb = r >> 6, nb = r & 63; conv_item_bf16(pa, 2048, kb * 128, nb * 32, pam, 4096, nb * 32, kb * 128, lane); continue; } r -= 1024;
            if (r < 1024) { const int kb = r >> 6, nb = r & 63; conv_item_bf16(pm, 2048, kb * 128, nb * 32, pam, 4096, nb * 32, 2048 + kb * 128, lane); continue; } r -= 1024;
            { const int kb = r >> 6, nb = r & 63; conv_item_bf16(wo, 2048, kb * 128, nb * 32, wout, 2048, nb * 32, kb * 128, lane); } }
    }
};

__device__ __forceinline__ void p0_prologue(Frame& F) {
    const int lane = lane_id(), tid = F.wave * 64 + lane; (void)tid;
    LAS float* scr = (LAS float*)(F.lds + F.wave * 16384);
    const int gw = F.bx * NWAVES + F.wave, NGW = F.G * NWAVES;
    const float* Win = INP(2);
    constexpr int I_IN = 16 * 512, I_P = 16 * 64;
    const int NITEMS = I_IN + (F.G == 256 ? 0 : 3 * I_P);
    for (int it = gw; it < NITEMS; it += NGW) {
        int r = it;
        if (r < I_IN) { const int kb = r >> 9, nb = r & 511, n0 = nb * 32;
            if (n0 < N_BF16_TILES * 256) conv_item_bf16(Win, INC, kb * 128, n0, (bf16*)(F.ws + WS_WIN), 2048, n0, kb * 128, lane);
            else conv_item_fp8(Win, INC, kb * 128, n0 < 12288 ? n0 : n0 + 8, (unsigned char*)(F.ws + WS_WIN8), 2048, n0 - N_BF16_TILES * 256, kb * 128, lane);
            continue; } r -= I_IN;
        if (r < I_P) { const int kb = r >> 6, nb = r & 63; conv_item_bf16(INP(11), 2048, kb * 128, nb * 32, (bf16*)(F.ws + WS_PAM), 4096, nb * 32, kb * 128, lane); continue; } r -= I_P;
        if (r < I_P) { const int kb = r >> 6, nb = r & 63; conv_item_bf16(INP(12), 2048, kb * 128, nb * 32, (bf16*)(F.ws + WS_PAM), 4096, nb * 32, 2048 + kb * 128, lane); continue; } r -= I_P;
        { const int kb = r >> 6, nb = r & 63; conv_item_bf16(INP(13), 2048, kb * 128, nb * 32, (bf16*)(F.ws + WS_WOUT), 2048, nb * 32, kb * 128, lane); }
    }
    { bf16* Wbd = (bf16*)(F.ws + WS_WBD); const float* wsgu = INP(6);
      for (int i = F.bx * NTHR + tid; i < 8 * 256 * 256; i += F.G * NTHR) { const int g = i >> 16, t = (i >> 8) & 255, s = i & 255; float v = 0.f;
          if ((t >> 7) == (s >> 7)) { const int tt = t & 127, ss = s & 127; if ((ss >> 6) <= (tt >> 6)) v = wsgu[(g * 128 + tt) * 128 + ss]; }
          Wbd[i] = (bf16)f2bf(v); } }
    __syncthreads();
    LAS float* wg = (LAS float*)F.lds;
    for (int i = tid; i < 2048 * 8; i += NTHR) { const int ch = i >> 3, q = i & 7; wg[(((((ch >> 8) * 4 + (ch & 3)) * 2 + (q >> 2)) * 64 + ((ch >> 2) & 63)) << 2) + (q & 3)] = Win[(size_t)ch * INC + 12288 + q]; }
    __syncthreads();
    const float* x = INP(0); const float* gmix = INP(1); const float* b_in = INP(3);
    bf16* H = (bf16*)(F.ws + WS_H); float* G8 = (float*)(F.ws + WS_G8);
    f32x4 gv[8], xn[8];
#pragma unroll
    for (int j = 0; j < 8; ++j) gv[j] = ((const f32x4*)gmix)[64 * j + lane];
    if (gw < T) {
#pragma unroll
        for (int j = 0; j < 8; ++j) xn[j] = ((const f32x4*)(x + (size_t)gw * D) + lane)[64 * j]; }
    for (int mrow = gw; mrow < T; mrow += NGW) {
        f32x4 xv[8]; float s = 0.f;
#pragma unroll
        for (int j = 0; j < 8; ++j) { xv[j] = xn[j]; s += (xv[j].x * xv[j].x + xv[j].y * xv[j].y) + (xv[j].z * xv[j].z + xv[j].w * xv[j].w); }
        if (mrow + NGW < T) {
#pragma unroll
            for (int j = 0; j < 8; ++j) xn[j] = ((const f32x4*)(x + (size_t)(mrow + NGW) * D) + lane)[64 * j]; }
        const float rstd = 1.0f / sqrtf(wave_sum(s) * (1.0f / D) + EPS);
        float ga[8];
#pragma unroll
        for (int q = 0; q < 8; ++q) ga[q] = 0.f;
        unsigned long long* o8 = (unsigned long long*)(H + (size_t)mrow * D) + lane;
#pragma unroll
        for (int j = 0; j < 8; ++j) { const f32x4 hv = xv[j] * rstd * gv[j];
            o8[64 * j] = (unsigned long long)pk2(hv.x, hv.y) | ((unsigned long long)pk2(hv.z, hv.w) << 32);
            ((unsigned*)((unsigned char*)(F.ws + WS_H8) + (size_t)mrow * D))[64 * j + lane] = pk4_fp8(hv.x, hv.y, hv.z, hv.w);
            const LAS float* wp = wg + j * 2048 + lane * 4;
#pragma unroll
            for (int i = 0; i < 4; ++i) { const f32x4 w0 = *(const LAS f32x4*)(wp + i * 512), w1 = *(const LAS f32x4*)(wp + i * 512 + 256);
                ga[0] += hv[i] * w0.x; ga[1] += hv[i] * w0.y; ga[2] += hv[i] * w0.z; ga[3] += hv[i] * w0.w; ga[4] += hv[i] * w1.x; ga[5] += hv[i] * w1.y; ga[6] += hv[i] * w1.z; ga[7] += hv[i] * w1.w; }
            asm volatile("" ::: "memory"); }
#pragma unroll
        for (int q = 0; q < 8; ++q) ga[q] = wave_sum(ga[q]);
        if (lane < 8) { float val = ga[0];
#pragma unroll
            for (int q = 1; q < 8; ++q) val = (lane == q) ? ga[q] : val;
            G8[(size_t)mrow * 8 + lane] = val + b_in[12288 + lane]; }
    }
    __syncthreads();
}

__device__ __forceinline__ void p2_elementwise(Frame& F) {
    const int lane = lane_id(), tid = F.wave * 64 + lane; (void)tid;
    if (F.bx < 16 && F.wave == 0) {
        const int bh = F.bx, b = bh >> 2, h = bh & 3; const float* gp = (const float*)(F.ws + WS_G8) + ((size_t)b * 2048 + lane * 32) * 8;
        float* aS = (float*)(F.ws + WS_AS) + bh * 2048 + lane * 32; float* Mt = (float*)(F.ws + WS_MT) + bh * 2048 + lane * 32; float* Bm = (float*)(F.ws + WS_BM) + bh * 2048 + lane * 32;
        float lf[32], av[32];
#pragma unroll
        for (int c = 0; c < 32; ++c) { const float fg = gp[c * 8 + 4 + h]; av[c] = gp[c * 8 + h]; lf[c] = fminf(fg, 0.f) - log1pf(expf(-fabsf(fg))); }
        double tot = 0.0;
#pragma unroll
        for (int c = 0; c < 32; ++c) tot += (double)lf[c];
#pragma unroll
        for (int o = 1; o < 64; o <<= 1) { const double t = __shfl_up(tot, o); if (lane >= o) tot += t; }
        double excl = __shfl_up(tot, 1); if (lane == 0) excl = 0.0;
        double run = excl; float lm = -3.0e38f;
#pragma unroll
        for (int c = 0; c < 32; ++c) { run += (double)lf[c]; av[c] -= (float)run; lm = fmaxf(lm, av[c]); }
#pragma unroll
        for (int o = 1; o < 64; o <<= 1) { const float t = __shfl_up(lm, o); if (lane >= o) lm = fmaxf(lm, t); }
        float mx = __shfl_up(lm, 1); if (lane == 0) mx = 0.f; mx = fmaxf(mx, 0.f);
        run = excl;
#pragma unroll
        for (int c4 = 0; c4 < 8; ++c4) { f32x4 a4, m4, b4;
#pragma unroll
            for (int j = 0; j < 4; ++j) { const int c = c4 * 4 + j; run += (double)lf[c]; mx = fmaxf(mx, av[c]); a4[j] = av[c]; m4[j] = mx; b4[j] = (float)(run + (double)mx); }
            *(f32x4*)(aS + c4 * 4) = a4; *(f32x4*)(Mt + c4 * 4) = m4; *(f32x4*)(Bm + c4 * 4) = b4; }
    }
    const int gt = F.bx * NTHR + tid, NT_ = F.G * NTHR;
    { const bf16* QKr = (const bf16*)(F.ws + WS_QKR); bf16* QKc = (bf16*)(F.ws + WS_QKC); const float* wc = INP(4); const float* bc = INP(5);
      const int c0 = (gt & 511) * 8; const float sc = (c0 < 2048) ? 0.04419417382f : 1.0f;
      f32x4 w[4][2];
#pragma unroll
      for (int k = 0; k < 4; ++k) { w[k][0] = *(const f32x4*)(wc + k * 4096 + c0); w[k][1] = *(const f32x4*)(wc + k * 4096 + c0 + 4); }
      const f32x4 b0 = *(const f32x4*)(bc + c0), b1 = *(const f32x4*)(bc + c0 + 4);
      for (int it = gt; it < (T / 4) * 512; it += 2 * NT_) { u32x4 z[2][7]; int tk[2];
#pragma unroll
          for (int q = 0; q < 2; ++q) { const int itq = it + q * NT_; const bool ok = itq < (T / 4) * 512; const int tok = ok ? (itq >> 9) * 4 : 0; tk[q] = ok ? tok : -1; const int s = tok & 2047;
#pragma unroll
              for (int r = 0; r < 7; ++r) { z[q][r] = (u32x4){0u, 0u, 0u, 0u}; if (r >= 3 || s > 0) z[q][r] = *(const u32x4*)(QKr + (size_t)(tok - 3 + r) * 4096 + c0); } }
#pragma unroll
          for (int q = 0; q < 2; ++q) { if (tk[q] < 0) continue;
#pragma unroll
              for (int o = 0; o < 4; ++o) { f32x4 a0 = b0, a1 = b1;
#pragma unroll
                  for (int k = 0; k < 4; ++k) { const u32x4 zz = z[q][o + k];
                      a0.x += bflo(zz.x) * w[k][0].x; a0.y += bfhi(zz.x) * w[k][0].y; a0.z += bflo(zz.y) * w[k][0].z; a0.w += bfhi(zz.y) * w[k][0].w;
                      a1.x += bflo(zz.z) * w[k][1].x; a1.y += bfhi(zz.z) * w[k][1].y; a1.z += bflo(zz.w) * w[k][1].z; a1.w += bfhi(zz.w) * w[k][1].w; }
#pragma unroll
                  for (int j = 0; j < 4; ++j) { a0[j] = a0[j] * sigmoidf_(a0[j]) * sc; a1[j] = a1[j] * sigmoidf_(a1[j]) * sc; }
                  u32x4 ov; ov.x = pk2(a0.x, a0.y); ov.y = pk2(a0.z, a0.w); ov.z = pk2(a1.x, a1.y); ov.w = pk2(a1.z, a1.w);
                  *(u32x4*)(QKc + (size_t)(tk[q] + o) * 4096 + c0) = ov; } } } }
    { bf16* VgT = (bf16*)(F.ws + WS_VGT); const float* vpart = (const float*)(F.ws + WS_VPART); const float* gln = INP(8); const float* bln = INP(9);
      LAS float* st = (LAS float*)(F.lds + MISC_OFF + 64);
      for (int bi = F.bx; bi < T / 32; bi += F.G) {
          const int xq = bi & 7, qq = (bi >> 3) & 31, hi_ = bi >> 8; const int blk = hi_ * 256 + 2 * (8 * (qq >> 1) + xq) + (qq & 1);
          const int tok0 = blk * 32, b = tok0 >> 11, s0 = tok0 & 2047;
          __syncthreads();
          if (tid < 32) { const f32x4* vp = (const f32x4*)(vpart + (size_t)(tok0 + tid) * 64); float sm = 0.f, sq = 0.f;
#pragma unroll
              for (int q = 0; q < 8; ++q) { const f32x4 a = vp[q], c = vp[8 + q]; sm += (a.x + a.y) + (a.z + a.w); sq += (c.x + c.y) + (c.z + c.w); }
              const float mu = sm * (1.0f / 2048.0f); const float var = fmaxf(sq * (1.0f / 2048.0f) - mu * mu, 0.f); st[tid] = mu; st[32 + tid] = 1.0f / sqrtf(var + EPS); }
          __syncthreads();
          u32x4 zv[16];
#pragma unroll
          for (int k = 0; k < 16; ++k) { const int i = tid + k * NTHR; const int d = i >> 2, grp = i & 3; zv[k] = *(const u32x4*)(VgT + ((size_t)(b * 2048 + d) * 2048 + s0 + grp * 8)); }
#pragma unroll
          for (int k = 0; k < 16; ++k) { const int i = tid + k * NTHR; const int d = i >> 2, grp = i & 3; bf16* p = VgT + ((size_t)(b * 2048 + d) * 2048 + s0 + grp * 8);
              const u32x4 z = zv[k]; const float gg = gln[d], bb = bln[d];
              float v[8] = {bflo(z.x), bfhi(z.x), bflo(z.y), bfhi(z.y), bflo(z.z), bfhi(z.z), bflo(z.w), bfhi(z.w)};
#pragma unroll
              for (int j = 0; j < 8; ++j) v[j] = (v[j] - st[grp * 8 + j]) * st[32 + grp * 8 + j] * gg + bb;
              u32x4 o; o.x = pk2(v[0], v[1]); o.y = pk2(v[2], v[3]); o.z = pk2(v[4], v[5]); o.w = pk2(v[6], v[7]);
              *(u32x4*)p = o; } }
      __syncthreads(); }
}

__device__ __forceinline__ void p5_ym(Frame& F) {
    const int lane = lane_id(), tid = F.wave * 64 + lane; (void)tid;
    const int gt = F.bx * NTHR + tid, NT_ = F.G * NTHR;
    const bf16* Hm = (const bf16*)(F.ws + WS_HM); const bf16* Og = (const bf16*)(F.ws + WS_OG); const float* ssqp = (const float*)(F.ws + WS_SSQP); const float* gn = INP(10);
    bf16* Y = (bf16*)(F.ws + WS_Y);
#pragma unroll 2
    for (int it = gt; it < T * 256; it += NT_) { const int tok = it >> 8, c0 = (it & 255) * 8, h = c0 >> 9;
        const f32x4 q0 = *(const f32x4*)(ssqp + (size_t)(tok * 4 + h) * 8), q1 = *(const f32x4*)(ssqp + (size_t)(tok * 4 + h) * 8 + 4);
        const float rstd = 1.0f / sqrtf((((q0.x + q0.y) + (q0.z + q0.w)) + ((q1.x + q1.y) + (q1.z + q1.w))) * (1.0f / 512.0f) + EPS);
        const u32x4 hv = *(const u32x4*)(Hm + (size_t)tok * 2048 + c0), ov = *(const u32x4*)(Og + (size_t)tok * 2048 + c0);
        const f32x4 g0 = *(const f32x4*)(gn + c0), g1 = *(const f32x4*)(gn + c0 + 4);
        u32x4 o; o.x = pk2(bflo(hv.x) * rstd * g0.x * bflo(ov.x), bfhi(hv.x) * rstd * g0.y * bfhi(ov.x)); o.y = pk2(bflo(hv.y) * rstd * g0.z * bflo(ov.y), bfhi(hv.y) * rstd * g0.w * bfhi(ov.y));
        o.z = pk2(bflo(hv.z) * rstd * g1.x * bflo(ov.z), bfhi(hv.z) * rstd * g1.y * bfhi(ov.z)); o.w = pk2(bflo(hv.w) * rstd * g1.z * bflo(ov.w), bfhi(hv.w) * rstd * g1.w * bfhi(ov.w));
        *(u32x4*)(Y + (size_t)tok * 4096 + 2048 + c0) = o; }
}

__device__ __forceinline__ void p8_router(Frame& F) {
    const int lane = lane_id(), tid = F.wave * 64 + lane; (void)tid;
    const float* x1 = (const float*)(F.ws + WS_X1); const float* gmoe = INP(14); const float* Wr = INP(15); const float* br = INP(16);
    LAS float* hT = (LAS float*)F.lds;
    LAS float* WrL = (LAS float*)(F.lds + 65536);
    LAS float* red = (LAS float*)(F.lds + 81920);
    LAS float* misc = (LAS float*)(F.lds + MISC_OFF + 64);
    LAS float* rstd_s = misc; LAS int* sel_e = (LAS int*)(misc + 32); LAS float* sel_g = misc + 32 + 128; LAS int* sel_pos = (LAS int*)(misc + 32 + 256);
    LAS int* lcnt = (LAS int*)(misc + 32 + 384); LAS int* lbase = lcnt + 32;
    if (tid < 32) lcnt[tid] = 0;
    int* ecnt = (int*)(F.ws + CTLB_ECNT); int* slot = (int*)(F.ws + WS_SLOT); float* slotg = (float*)(F.ws + WS_SLOT + 128 * 1024);
    unsigned char* Xs = (unsigned char*)(F.ws + WS_XS);
    for (int tb = F.bx; tb < T / 32; tb += F.G) {
        const int tok0 = tb * 32;
        float accr[16];
#pragma unroll
        for (int q = 0; q < 16; ++q) accr[q] = 0.f;
        float ssl[4] = {0.f, 0.f, 0.f, 0.f};
        float xv[8][4], gq[8]; f32x4 wv[8];
#define ROUTER_ISSUE(qq) do { _Pragma("unroll") for (int i = 0; i < 8; ++i) { const int c = 64 * i + lane; gq[i] = gmoe[(qq) * 512 + c]; \
            _Pragma("unroll") for (int r = 0; r < 4; ++r) xv[i][r] = x1[(size_t)(tok0 + F.wave * 4 + r) * D + (qq) * 512 + c]; \
            wv[i] = ((const f32x4*)(Wr + (size_t)(qq) * 512 * 32))[i * NTHR + tid]; } } while (0)
        ROUTER_ISSUE(0);
#pragma unroll 1
        for (int qt = 0; qt < 4; ++qt) {
            __syncthreads();
#pragma unroll
            for (int i = 0; i < 8; ++i) { const int c = 64 * i + lane; f32x4 hv;
#pragma unroll
                for (int r = 0; r < 4; ++r) { const float v = xv[i][r]; ssl[r] += v * v; hv[r] = v * gq[i]; }
                *(LAS f32x4*)(hT + c * 32 + ((4 * F.wave) ^ ((c & 7) << 2))) = hv;
                *(LAS f32x4*)(WrL + (size_t)(i * NTHR + tid) * 4) = wv[i]; }
            if (qt < 3) ROUTER_ISSUE(qt + 1);
            __syncthreads();
            const int tg = lane & 7, eg = lane >> 3;
#pragma unroll 8
            for (int cc = 0; cc < 64; ++cc) { const int c = F.wave * 64 + cc; const f32x4 h4 = *(const LAS f32x4*)(hT + c * 32 + ((4 * tg) ^ ((c & 7) << 2))); const f32x4 w4 = *(const LAS f32x4*)(WrL + c * 32 + 4 * eg);
#pragma unroll
                for (int a = 0; a < 4; ++a) { accr[a * 4 + 0] += h4[a] * w4.x; accr[a * 4 + 1] += h4[a] * w4.y; accr[a * 4 + 2] += h4[a] * w4.z; accr[a * 4 + 3] += h4[a] * w4.w; } }
        }
#undef ROUTER_ISSUE
        __syncthreads();
#pragma unroll
        for (int r = 0; r < 4; ++r) { const float s = wave_sum(ssl[r]); if (lane == 0) rstd_s[F.wave * 4 + r] = 1.0f / sqrtf(s * (1.0f / D) + EPS); }
#pragma unroll
        for (int q = 0; q < 16; ++q) red[(F.wave * 64 + lane) * 17 + q] = accr[q];
        __syncthreads();
        LAS float* lg = (LAS float*)(F.lds + 81920 + 36864);
        for (int o = tid; o < 1024; o += NTHR) { const int tl = o >> 5, e = o & 31; const int ln = (e >> 2) * 8 + (tl >> 2), q = (tl & 3) * 4 + (e & 3); float s = 0.f;
#pragma unroll
            for (int w = 0; w < 8; ++w) s += red[(w * 64 + ln) * 17 + q];
            lg[tl * 33 + e] = s * rstd_s[tl] + br[e]; }
        __syncthreads();
        int id[4]; float gk[4]; int lr[4];
        if (tid < 32) { const int tl = tid; float v[4]; unsigned used = 0u;
#pragma unroll
            for (int k = 0; k < 4; ++k) { float best = -3.0e38f; int bi = 0;
                for (int e = 0; e < 32; ++e) { const float x = lg[tl * 33 + e]; if (!((used >> e) & 1u) && x > best) { best = x; bi = e; } }
                used |= 1u << bi; v[k] = best; id[k] = bi; }
            const float e1 = fast_exp(v[1] - v[0]), e2 = fast_exp(v[2] - v[0]), e3 = fast_exp(v[3] - v[0]); const float inv = 1.0f / (1.0f + e1 + e2 + e3);
            gk[0] = inv; gk[1] = e1 * inv; gk[2] = e2 * inv; gk[3] = e3 * inv;
#pragma unroll
            for (int k = 0; k < 4; ++k) lr[k] = atomicAdd((int*)(lcnt + id[k]), 1);
        }
        __syncthreads();
        if (tid < 32) { const int n = lcnt[tid]; lbase[tid] = n ? atomicAdd(ecnt + tid * 64, n) : 0; }
        __syncthreads();
        if (tid < 32) { const int tl = tid;
#pragma unroll
            for (int k = 0; k < 4; ++k) { const int pos = lbase[id[k]] + lr[k]; sel_e[tl * 4 + k] = id[k]; sel_g[tl * 4 + k] = gk[k]; sel_pos[tl * 4 + k] = pos;
                slot[(size_t)(tok0 + tl) * 4 + k] = (id[k] << 16) | pos; slotg[(size_t)(tok0 + tl) * 4 + k] = gk[k]; }
            lcnt[tl] = 0; }
        __syncthreads();
#pragma unroll
        for (int r = 0; r < 4; ++r) { const int tl = F.wave * 4 + r; const float rs = rstd_s[tl]; const f32x4* xr = (const f32x4*)(x1 + (size_t)(tok0 + tl) * D) + lane;
            unsigned pk[8];
#pragma unroll
            for (int j = 0; j < 8; ++j) { const f32x4 v = xr[64 * j]; const f32x4 gg = ((const f32x4*)gmoe)[64 * j + lane];
                pk[j] = pk4_fp8(v.x * rs * gg.x, v.y * rs * gg.y, v.z * rs * gg.z, v.w * rs * gg.w); }
#pragma unroll
            for (int k = 0; k < 4; ++k) { const int e = sel_e[tl * 4 + k], pos = sel_pos[tl * 4 + k]; unsigned* o4 = (unsigned*)(Xs + ((size_t)e * CAP + pos) * D) + lane;
#pragma unroll
                for (int j = 0; j < 8; ++j) o4[64 * j] = pk[j]; } }
    }
    __syncthreads();
}

__device__ __forceinline__ void moe_table(Frame& F, volatile LAS int* tab, int NT) {
    const int lane = lane_id(), tid = F.wave * 64 + lane;
    __syncthreads();
    if (tid < 64) { const int* ecnt = (const int*)(F.ws + CTLB_ECNT); const int e = lane & 31;
        const int cnt = __hip_atomic_load(ecnt + e * 64, __ATOMIC_RELAXED, __HIP_MEMORY_SCOPE_AGENT); const int t = (cnt + 255) >> 8;
        if ((F.G & 7) == 0) { const int x = F.bx & 7; int rank = 0;
            for (int k = 0; k < 32; ++k) { const int tk = __shfl(t, k); rank += (tk > t || (tk == t && k < e)) ? 1 : 0; }
            const int rnd = rank >> 3, pos = rank & 7, g = (rnd & 1) ? 7 - pos : pos;
            if (lane < 32 && g == x) { tab[40 + rnd] = t; tab[48 + rnd] = e; }
            LDS_WAIT(); asm volatile("" ::: "memory");
            if (lane == 0) { int pre = 0; tab[0] = 0; for (int j = 0; j < 4; ++j) { pre += tab[40 + j] * NT; tab[j + 1] = pre; } }
        } else { int pre = t * NT;
#pragma unroll
            for (int o = 1; o < 32; o <<= 1) { const int v = __shfl_up(pre, o); if ((lane & 31) >= o) pre += v; }
            if (lane < 32) { tab[e + 1] = pre; tab[40 + e] = t; tab[80 + e] = e; if (e == 0) tab[0] = 0; } }
    }
    __syncthreads();
}

__device__ __forceinline__ void p11_combine(Frame& F) {
    const int lane = lane_id(), tid = F.wave * 64 + lane; (void)tid;
    const int gw = F.bx * NWAVES + F.wave, NGW = F.G * NWAVES;
    const float* x1 = (const float*)(F.ws + WS_X1); const bf16* Ye = (const bf16*)(F.ws + WS_YE); const int* slot = (const int*)(F.ws + WS_SLOT); const float* slotg = (const float*)(F.ws + WS_SLOT + 128 * 1024);
    const float* gf = INP(21); float* outp = OUTP();
    for (int tok0 = gw; tok0 < T; tok0 += 2 * NGW) {
        const int tokb = (tok0 + NGW < T) ? tok0 + NGW : tok0; int sl[2][4]; float gk[2][4];
#pragma unroll
        for (int q = 0; q < 2; ++q) { const int tok = q ? tokb : tok0; const int4 s4 = *(const int4*)(slot + (size_t)tok * 4); const f32x4 g4 = *(const f32x4*)(slotg + (size_t)tok * 4);
            sl[q][0] = s4.x; sl[q][1] = s4.y; sl[q][2] = s4.z; sl[q][3] = s4.w; gk[q][0] = g4.x; gk[q][1] = g4.y; gk[q][2] = g4.z; gk[q][3] = g4.w; }
        f32x4 v[2][8]; unsigned long long y[2][4][8];
#pragma unroll
        for (int q = 0; q < 2; ++q) { const int tok = q ? tokb : tok0; const f32x4* xr = (const f32x4*)(x1 + (size_t)tok * D) + lane;
#pragma unroll
            for (int j = 0; j < 8; ++j) v[q][j] = xr[64 * j]; }
#pragma unroll
        for (int q = 0; q < 2; ++q)
#pragma unroll
            for (int k = 0; k < 4; ++k) { const int e = sl[q][k] >> 16, pos = sl[q][k] & 0xffff; const unsigned long long* yr = (const unsigned long long*)(Ye + ((size_t)e * CAP + pos) * D) + lane;
#pragma unroll
                for (int j = 0; j < 8; ++j) y[q][k][j] = yr[64 * j]; }
#pragma unroll
        for (int q = 0; q < 2; ++q) { const int tok = q ? tokb : tok0;
#pragma unroll
            for (int k = 0; k < 4; ++k)
#pragma unroll
                for (int j = 0; j < 8; ++j) { const unsigned lo = (unsigned)y[q][k][j], hi = (unsigned)(y[q][k][j] >> 32); const float g = gk[q][k];
                    v[q][j].x += g * bflo(lo); v[q][j].y += g * bfhi(lo); v[q][j].z += g * bflo(hi); v[q][j].w += g * bfhi(hi); }
            float s = 0.f;
#pragma unroll
            for (int j = 0; j < 8; ++j) s += (v[q][j].x * v[q][j].x + v[q][j].y * v[q][j].y) + (v[q][j].z * v[q][j].z + v[q][j].w * v[q][j].w);
            const float rstd = 1.0f / sqrtf(wave_sum(s) * (1.0f / D) + EPS);
            f32x4* orow = (f32x4*)(outp + (size_t)tok * D) + lane;
            if (q == 0 || tokb != tok0) {
#pragma unroll
                for (int j = 0; j < 8; ++j) { const f32x4 gg = ((const f32x4*)gf)[64 * j + lane]; orow[64 * j] = v[q][j] * rstd * gg; } } }
    }
}

constexpr int N_PHASES = 13;
__global__ void __launch_bounds__(NTHR, 2) mk_fwd(Args args) {
    extern __shared__ __attribute__((aligned(16))) unsigned char lds_raw[];
    Frame F; F.lds = (LAS unsigned char*)lds_raw; F.wave = __builtin_amdgcn_readfirstlane((int)threadIdx.x >> 6); F.G = gridDim.x; F.bx = blockIdx.x;
    const int tid = F.wave * 64 + lane_id();
    F.ws = WSP();
    volatile LAS unsigned* MISC = (volatile LAS unsigned*)(F.lds + MISC_OFF);
    for (int i = tid; i < 256; i += NTHR) MISC[i] = 0u;
    __syncthreads();
    if (MK_N_LAUNCHES == 1) (void)xcd_barrier_post((unsigned*)(F.ws + WS_CTL) + 4096, MISC, tid == 0);
#define GRIDBAR() do { XcdBarrier _b; _b.bar = (unsigned*)(WSP() + WS_CTL) + 4096; _b.x = xb_xcc_id(); _b.st = (volatile LAS unsigned*)(F.lds + MISC_OFF); _b.G = (unsigned)F.G; xcd_barrier(_b, F.wave); } while (0)
    const int lo = args.ph_lo, hi = args.ph_hi;
#ifdef PH_ONLY
#define IN(k) ((k) == PH_ONLY && lo <= (k) && (k) < hi)
#else
#define IN(k) (lo <= (k) && (k) < hi)
#endif
#define SEAM(k) do { if (IN(k) && IN((k) + 1)) GRIDBAR(); } while (0)
#ifdef PROBE_DUP
#define REP(k) for (int _r = 0; _r < ((k) == PROBE_DUP ? 2 : 1); ++_r, ((k) == PROBE_DUP && _r == 1) ? ({ GRIDBAR(); }) : (void)0)
#else
#define REP(k)
#endif
    LAS unsigned char* ring = F.lds;
    if (lane_id() == 0) *((volatile LAS int*)(F.lds + MISC_OFF + 3072) + F.wave) = 0;
#define MKHOOK() const ConvHook HK{INP(17), INP(19), (unsigned char*)(F.ws + WS_WGU), (unsigned char*)(F.ws + WS_WD), (volatile LAS int*)(F.lds + MISC_OFF + 3072) + F.wave, F.bx * NWAVES + F.wave, F.G * NWAVES}
    volatile LAS int* tab = (volatile LAS int*)(F.lds + MISC_OFF + 4096);

    if (IN(0)) REP(0) { F.ws = WSP(); unsigned char* const ws = F.ws; (void)ws; p0_prologue(F); } SEAM(0);
    if (IN(1)) REP(1) { F.ws = WSP(); unsigned char* const ws = F.ws; (void)ws;
        EpiIn E{INP(3), ws};
        MKHOOK(); const int grp3 = (F.bx >> 3) % 3; if (grp3 == 0) HK.run(CONV_ITEMS_PER_WAVE, lane_id());
        { SchedGrid S{(const char*)(ws + WS_H), (const char*)(ws + WS_WIN), 4096u, 4096u, 32, N_BF16_TILES, F.G, F.bx, 32};
          pg8::gemm_phase<EpiIn, SchedGrid, ConvHook>(ring, F.wave, pg8::Gemm{4096u, 4096u}, S, E, HK, grp3 == 1 ? CONV_ITEMS_PER_WAVE : 0, 2); }
        { SchedGrid S{(const char*)(ws + WS_H8), (const char*)(ws + WS_WIN8), 2048u, 2048u, 32, N_FP8_TILES, F.G, F.bx, 16, N_BF16_TILES};
          pg8::gemm_phase<EpiIn, SchedGrid, ConvHook, true>(ring, F.wave, pg8::Gemm{2048u, 2048u}, S, E, HK, grp3 == 2 ? CONV_ITEMS_PER_WAVE : 0, -2); }
    } SEAM(1);
    if (IN(2)) REP(2) { F.ws = WSP(); unsigned char* const ws = F.ws; (void)ws; p2_elementwise(F); } SEAM(2);
    if (IN(3)) REP(3) { F.ws = WSP(); unsigned char* const ws = F.ws; (void)ws;
        SchedSgu S{(const char*)(ws + WS_WBD), (const char*)(ws + WS_VGT), F.G, F.bx};
        EpiSgu E{(const bf16*)(ws + WS_UG), INP(7), (bf16*)(ws + WS_Y)};
        MKHOOK(); pg8::gemm_phase<EpiSgu, SchedSgu, ConvHook>(ring, F.wave, pg8::Gemm{512u, 4096u}, S, E, HK, 0);
    }
    if (IN(4)) REP(4) { F.ws = WSP(); unsigned char* const ws = F.ws; (void)ws;
        SchedQK S{(const char*)(ws + WS_QKC), F.G, F.bx};
        EpiQK E{(const float*)(ws + WS_AS), (const float*)(ws + WS_MT), (bf16*)(ws + WS_P), (float*)(ws + WS_DENP)};
        const ConvPoolB HP{INP(11), INP(12), INP(13), (bf16*)(ws + WS_PAM), (bf16*)(ws + WS_WOUT), ((F.bx - 64) * NWAVES + F.wave) * 2, (F.G == 256 && F.bx >= 64) ? 2 : 0};
        pg8::gemm_phase<EpiQK, SchedQK, ConvPoolB>(ring, F.wave, pg8::Gemm{8192u, 8192u}, S, E, HP, 1, -2);
    } SEAM(4);
    if (IN(5)) REP(5) { F.ws = WSP(); unsigned char* const ws = F.ws; (void)ws;
        SchedPV S{(const char*)(ws + WS_P), (const char*)(ws + WS_VMT), F.G, F.bx};
        EpiPV E{(const float*)(ws + WS_DENP), (const float*)(ws + WS_BM), (bf16*)(ws + WS_HM), (float*)(ws + WS_SSQP)};
        MKHOOK(); const int g5 = (F.bx >> 5) & 7, n5 = (int)((CONV_P5_N >> (4 * g5)) & 15u), pre5 = (int)((CONV_P5_PRE >> (8 * g5)) & 255ull);
        const ConvPool HP{HK, CONV_POOL5 + 256 * pre5 + ((F.bx & 31) * NWAVES + F.wave) * n5, (F.G == 256) ? n5 : 0};
        pg8::gemm_phase<EpiPV, SchedPV, ConvPool>(ring, F.wave, pg8::Gemm{4096u, 4096u}, S, E, HP, 1, -2);
    } SEAM(5);
    if (IN(6)) REP(6) { F.ws = WSP(); unsigned char* const ws = F.ws; (void)ws; p5_ym(F); } SEAM(6);
    if (IN(7)) REP(7) { F.ws = WSP(); unsigned char* const ws = F.ws; (void)ws;
        SchedMerge S{(const char*)(ws + WS_Y), (const char*)(ws + WS_PAM), F.G, F.bx};
        EpiMerge E{(const bf16*)(ws + WS_GA), (const bf16*)(ws + WS_GM), (bf16*)(ws + WS_MRG)};
        MKHOOK(); pg8::gemm_phase<EpiMerge, SchedMerge, ConvHook>(ring, F.wave, pg8::Gemm{8192u, 8192u}, S, E, HK, 0);
    } SEAM(7);
    if (IN(8)) REP(8) { F.ws = WSP(); unsigned char* const ws = F.ws; (void)ws;
        SchedGrid S{(const char*)(ws + WS_MRG), (const char*)(ws + WS_WOUT), 4096u, 4096u, 32, 8, F.G, F.bx, 32};
        EpiX1 E{INP(0), (float*)(ws + WS_X1)};
        MKHOOK(); pg8::gemm_phase<EpiX1, SchedGrid, ConvHook>(ring, F.wave, pg8::Gemm{4096u, 4096u}, S, E, HK, 0);
    } SEAM(8);
    if (IN(9)) REP(9) { F.ws = WSP(); unsigned char* const ws = F.ws; (void)ws; p8_router(F); MKHOOK(); HK.run(1000, lane_id()); } SEAM(9);
    if (IN(10)) REP(10) { F.ws = WSP(); unsigned char* const ws = F.ws; (void)ws;
        moe_table(F, tab, 16);
        { SchedMoe2 S{(const char*)(ws + WS_XS), (const char*)(ws + WS_HA), (const char*)(ws + WS_WGU), (const char*)(ws + WS_WD), tab, F.G, F.bx, nullptr, nullptr, 0};
          EpiGU E{INP(18), (unsigned char*)(ws + WS_HA)};
          pg8::gemm_phase<EpiGU, SchedMoe2, NoHook, true>(ring, F.wave, pg8::Gemm{2048u, 2048u}, S, E); }
    } SEAM(10);
    if (IN(11)) REP(11) { F.ws = WSP(); unsigned char* const ws = F.ws; (void)ws;
        { SchedMoe2 S{(const char*)(ws + WS_XS), (const char*)(ws + WS_HA), (const char*)(ws + WS_WGU), (const char*)(ws + WS_WD), tab, F.G, F.bx, nullptr, nullptr, 1};
          EpiDown E{INP(20), (bf16*)(ws + WS_YE)};
          pg8::gemm_phase<EpiDown, SchedMoe2, NoHook, true>(ring, F.wave, pg8::Gemm{2048u, 2048u}, S, E); }
    }
    SEAM(11);
    if (IN(12)) REP(12) { F.ws = WSP(); unsigned char* const ws = F.ws; (void)ws; p11_combine(F); }
#undef IN
#undef SEAM
}

extern "C" void kernel_launch(void* const* d_in, const int* in_sizes, int n_in, void* d_out, int out_size, void* d_ws, size_t ws_size, hipStream_t stream) {
    static int grid = 0;
    if (grid == 0) {
        if (n_in != 22 || out_size != T * D || ws_size < WS_END) { fprintf(stderr, "kernel_launch: unexpected shapes (n_in %d out %d ws %zu need %zu)\n", n_in, out_size, ws_size, (size_t)WS_END); grid = -1; return; }
        int dev = 0, cus = 0, per_cu = 0;
        if (hipGetDevice(&dev) != hipSuccess || hipDeviceGetAttribute(&cus, hipDeviceAttributeMultiprocessorCount, dev) != hipSuccess) { grid = -1; return; }
        if (hipFuncSetAttribute((const void*)mk_fwd, hipFuncAttributeMaxDynamicSharedMemorySize, LDS_BYTES) != hipSuccess) { fprintf(stderr, "kernel_launch: hipFuncSetAttribute failed\n"); grid = -1; return; }
        if (hipOccupancyMaxActiveBlocksPerMultiprocessor(&per_cu, (const void*)mk_fwd, NTHR, LDS_BYTES) != hipSuccess || per_cu < 1) fprintf(stderr, "kernel_launch: occupancy query says %d\n", per_cu);
        (void)hipGetLastError();
        grid = cus;
    }
    if (grid < 0) return;
    (void)in_sizes;
    hipMemsetAsync((char*)d_ws + WS_CTL, 0, CTL_ZERO_BYTES, stream);
    Args a{};
    for (int i = 0; i < 22; ++i) a.in[i] = (const float*)d_in[i];
    a.out = (float*)d_out; a.ws = (unsigned char*)d_ws;
    if (MK_N_LAUNCHES == 1) { a.ph_lo = 0; a.ph_hi = N_PHASES; a.li = 0; hipLaunchKernelGGL(mk_fwd, dim3(grid), dim3(NTHR), LDS_BYTES, stream, a); }
    else { for (int p = 0; p < N_PHASES; ++p) { a.ph_lo = p; a.ph_hi = p + 1; a.li = p; hipLaunchKernelGGL(mk_fwd, dim3(grid), dim3(NTHR), LDS_BYTES, stream, a); } }
}
```

```cpp
#include <hip/hip_runtime.h>
#include <cstdio>
#include <cstdint>

#ifndef MK_N_LAUNCHES
#define MK_N_LAUNCHES 1
#endif

#define GAS __attribute__((address_space(1)))
#define LAS __attribute__((address_space(3)))
typedef unsigned short bf16;
typedef short bf16x8 __attribute__((ext_vector_type(8)));
typedef short bf16x16 __attribute__((ext_vector_type(16)));
typedef int i32x8 __attribute__((ext_vector_type(8)));
typedef int i32x4 __attribute__((ext_vector_type(4)));
typedef float f32x4 __attribute__((ext_vector_type(4)));
typedef float f32x2 __attribute__((ext_vector_type(2)));
typedef unsigned u32x4 __attribute__((ext_vector_type(4)));
typedef unsigned u32x2 __attribute__((ext_vector_type(2)));

constexpr int D = 2048, NB = 4, SEQ = 2048, T = NB * SEQ;
constexpr int INC = 16392;
constexpr int NH = 4, DH = 512, NE = 32, TOPK = 4, FF = 2048, CAP = 8192;
constexpr int N_BF16_TILES = 40, N_FP8_TILES = 24;
constexpr float EPS = 1e-6f;
constexpr int NWAVES = 8, NTHR = 512;

constexpr size_t MiB = 1u << 20;
constexpr size_t WS_CTL = 0, CTL_ZERO_BYTES = 128 * 1024;
constexpr size_t CTLB_ECNT = 32 * 1024;
constexpr size_t CTLB_TMO = 48 * 1024;
constexpr size_t CTLB_HCNT = 64 * 1024;
constexpr size_t WS_G8 = 1 * MiB;
constexpr size_t WS_AS = WS_G8 + 512 * 1024;
constexpr size_t WS_MT = WS_AS + 128 * 1024;
constexpr size_t WS_BM = WS_MT + 128 * 1024;
constexpr size_t WS_SLOT = 2 * MiB;
constexpr size_t WS_WBD = 3 * MiB;
constexpr size_t WS_WIN = 4 * MiB;
constexpr size_t WS_PAM = WS_WIN + 64 * MiB;
constexpr size_t WS_WOUT = WS_PAM + 16 * MiB;
constexpr size_t WS_WGU = WS_WOUT + 8 * MiB;
constexpr size_t WS_WD = WS_WGU + 512 * MiB;
constexpr size_t WS_H = WS_WD + 256 * MiB;
constexpr size_t WS_UG = WS_H + 32 * MiB;
constexpr size_t WS_VGT = WS_UG + 32 * MiB;
constexpr size_t WS_QKR = WS_VGT + 32 * MiB;
constexpr size_t WS_QKC = WS_QKR + 64 * MiB;
constexpr size_t WS_VMT = WS_QKC + 64 * MiB;
constexpr size_t WS_OG = WS_VMT + 32 * MiB;
constexpr size_t WS_GA = WS_OG + 32 * MiB;
constexpr size_t WS_GM = WS_GA + 32 * MiB;
constexpr size_t WS_P = WS_GM + 32 * MiB;
constexpr size_t WS_HM = WS_P + 128 * MiB;
constexpr size_t WS_Y = WS_HM + 32 * MiB;
constexpr size_t WS_MRG = WS_Y + 64 * MiB;
constexpr size_t WS_X1 = WS_MRG + 32 * MiB;
constexpr size_t WS_XS = WS_X1 + 64 * MiB;
constexpr size_t WS_HA = WS_XS + 512 * MiB;
constexpr size_t WS_YE = WS_XS + 1024 * MiB;
constexpr size_t WS_DENP = WS_YE + 1024 * MiB;
constexpr size_t WS_VPART = WS_DENP + 4 * MiB;
constexpr size_t WS_SSQP = WS_VPART + 2 * MiB;
constexpr size_t WS_H8 = WS_SSQP + 1 * MiB;
constexpr size_t WS_WIN8 = WS_H8 + 16 * MiB;
constexpr size_t WS_END = WS_WIN8 + 12 * MiB;

constexpr int RING_BYTES = 131072;
constexpr int MISC_OFF = RING_BYTES;
constexpr int LDS_BYTES = 147456;

#define LDS_WAIT() asm volatile("s_waitcnt lgkmcnt(0)" ::: "memory")
#define VM_WAIT() asm volatile("s_waitcnt vmcnt(0)" ::: "memory")

__device__ __forceinline__ unsigned f2bf(float f) { unsigned u = __builtin_bit_cast(unsigned, f); return (u + 0x7fffu + ((u >> 16) & 1u)) >> 16; }
__device__ __forceinline__ unsigned pk2(float lo, float hi) { return f2bf(lo) | (f2bf(hi) << 16); }
__device__ __forceinline__ float bflo(unsigned w) { return __builtin_bit_cast(float, w << 16); }
__device__ __forceinline__ float bfhi(unsigned w) { return __builtin_bit_cast(float, w & 0xffff0000u); }
__device__ __forceinline__ float bf2f(bf16 b) { return __builtin_bit_cast(float, ((unsigned)b) << 16); }
__device__ __forceinline__ unsigned cvt_pk_bf16(float lo, float hi) { unsigned r; asm volatile("v_cvt_pk_bf16_f32 %0, %1, %2" : "=v"(r) : "v"(lo), "v"(hi)); return r; }
__device__ __forceinline__ unsigned pk4_fp8(float a, float b, float c, float d) {
    a = __builtin_amdgcn_fmed3f(a, -448.f, 448.f); b = __builtin_amdgcn_fmed3f(b, -448.f, 448.f); c = __builtin_amdgcn_fmed3f(c, -448.f, 448.f); d = __builtin_amdgcn_fmed3f(d, -448.f, 448.f);
    int r = __builtin_amdgcn_cvt_pk_fp8_f32(a, b, 0, false); r = __builtin_amdgcn_cvt_pk_fp8_f32(c, d, r, true); return (unsigned)r; }
__device__ __forceinline__ float fast_exp(float x) { return __builtin_amdgcn_exp2f(x * 1.44269504089f); }
__device__ __forceinline__ float sigmoidf_(float x) { return __builtin_amdgcn_rcpf(1.0f + fast_exp(-x)); }
__device__ __forceinline__ int lane_id() { int l; asm volatile("v_mbcnt_lo_u32_b32 %0, -1, 0\n\tv_mbcnt_hi_u32_b32 %0, -1, %0" : "=v"(l)); return l; }
__device__ __forceinline__ const char* uniform_ptr(const char* p) {
    const unsigned long long v = (unsigned long long)p; const unsigned lo = (unsigned)__builtin_amdgcn_readfirstlane((int)(unsigned)v), hi = (unsigned)__builtin_amdgcn_readfirstlane((int)(unsigned)(v >> 32));
    return (const char*)(((unsigned long long)hi << 32) | lo); }
__device__ __forceinline__ float wave_sum(float v) {
#pragma unroll
    for (int o = 1; o < 64; o <<= 1) v += __shfl_xor(v, o);
    return v;
}

#define XB_TMO      128
#define XB_XCNT(j)  (256  + 64 * (j))
#define XB_XSUB(j)  (1280 + 64 * (j))
#define XB_XGEN(j)  (2304 + 64 * (j))
#define XB_TOP      3328
#define XB_TOPGEN   3392
#define XCD_BAR_WORDS 3456
#define XB_SPIN_CAP (1u << 18)
__device__ __forceinline__ unsigned xb_ld(unsigned* p)              { return __hip_atomic_load(p, __ATOMIC_RELAXED, __HIP_MEMORY_SCOPE_AGENT); }
__device__ __forceinline__ unsigned xb_add(unsigned* p, unsigned v) { return __hip_atomic_fetch_add(p, v, __ATOMIC_RELAXED, __HIP_MEMORY_SCOPE_AGENT); }
__device__ __forceinline__ unsigned xb_xcc_id() { return (unsigned)__builtin_amdgcn_s_getreg((3 << 11) | 20) & 0xFu; }
#define XB_SPIN(cond, bar) do { unsigned _sp = 0; while (cond) { __builtin_amdgcn_s_sleep(1); \
    if ((++_sp & 255u) == 0u) { if (xb_ld(&(bar)[XB_TMO])) break; if (_sp > XB_SPIN_CAP) { atomicAdd(&(bar)[XB_TMO], 1u); break; } } } } while (0)
struct XcdBarrier { unsigned* bar; unsigned x; volatile LAS unsigned* st; unsigned G; };
__device__ __forceinline__ XcdBarrier xcd_barrier_post(unsigned* bar, volatile LAS unsigned* st, bool leader) {
    XcdBarrier b; b.bar = bar; b.x = xb_xcc_id(); b.st = st; b.G = 0u;
    if (leader) (void)xb_add(&bar[XB_XCNT(b.x)], 1u);
    return b;
}
__device__ __forceinline__ void xcd_barrier_complete(unsigned* bar, unsigned x, unsigned& nloc, unsigned& nx, const unsigned G) {
    unsigned sum, cnt, mine, sp = 0u;
    for (;;) {
        sum = 0u; cnt = 0u; mine = 0u;
#pragma unroll
        for (unsigned j = 0; j < 16; ++j) { const unsigned c = xb_ld(&bar[XB_XCNT(j)]); sum += c; cnt += (c > 0u) ? 1u : 0u; mine = (j == x) ? c : mine; }
        if (sum == G) break;
        __builtin_amdgcn_s_sleep(1);
        if ((++sp & 255u) == 0u) { if (xb_ld(&bar[XB_TMO])) break; if (sp > XB_SPIN_CAP) { atomicAdd(&bar[XB_TMO], 1u); break; } }
    }
    nloc = mine > 0u ? mine : 1u; nx = cnt > 0u ? cnt : 1u;
}
__device__ __forceinline__ void xcd_barrier(const XcdBarrier& b, int wave) {
    asm volatile("s_waitcnt vmcnt(0)" ::: "memory");
    __syncthreads();
    if (wave == 0 && lane_id() == 0) {
        unsigned* bar = b.bar;
        __builtin_amdgcn_s_waitcnt(0);
        unsigned nloc = b.st[0], nx = b.st[1];
        if (nloc == 0u) { xcd_barrier_complete(bar, b.x, nloc, nx, b.G); b.st[0] = nloc; b.st[1] = nx; }
        const unsigned old = xb_add(&bar[XB_XSUB(b.x)], 1u);
        const unsigned gen = old / nloc;
        if (old + 1u == (gen + 1u) * nloc) {
            __builtin_amdgcn_fence(__ATOMIC_RELEASE, "agent");
            asm volatile("s_waitcnt vmcnt(0)" ::: "memory");
            const unsigned og = xb_add(&bar[XB_TOP], 1u);
            const unsigned tg = og / nx;
            if (og + 1u == (tg + 1u) * nx) xb_add(&bar[XB_TOPGEN], 1u);
            else XB_SPIN(xb_ld(&bar[XB_TOPGEN]) == tg, bar);
            __builtin_amdgcn_fence(__ATOMIC_ACQUIRE, "agent");
            xb_add(&bar[XB_XGEN(b.x)], 1u);
            asm volatile("s_waitcnt vmcnt(0)" ::: "memory");
        } else {
            XB_SPIN(xb_ld(&bar[XB_XGEN(b.x)]) == gen, bar);
            __builtin_amdgcn_fence(__ATOMIC_ACQUIRE, "agent");
            asm volatile("s_waitcnt vmcnt(0)" ::: "memory");
        }
    }
    __syncthreads();
}


constexpr int CONV_ITEMS = 98304;
constexpr int CONV_ITEMS_PER_WAVE = 1 << 20;
constexpr int CONV_P1_PER_WAVE = 44;
constexpr int CONV_POOL5 = 2048 * CONV_P1_PER_WAVE;
constexpr unsigned CONV_P5_N = 0xB8642100u; constexpr unsigned long long CONV_P5_PRE = 0x150D070301000000ull;
static_assert(CONV_POOL5 + 256 * 32 == CONV_ITEMS, "pool sizes");
struct ConvHook {
    const float* wgu; const float* wd; unsigned char* wguT; unsigned char* wdT; volatile LAS int* cnt; int gw, nw;
    __device__ __forceinline__ void load_item(int it, int lane, f32x4 (&v)[16], unsigned char*& dst) const {
        const int kg = lane >> 3, ng = lane & 7; const float* s; size_t pitch;
        if (it < 65536) { const int e = it >> 11, rr = it & 2047, kb = rr >> 7, nb = rr & 127, n0 = nb * 32, nn = n0 & 2047, drow = (nn >> 7) * 256 + (n0 >= 2048 ? 128 : 0) + (nn & 127);
            s = wgu + (size_t)e * 2048 * 4096 + (size_t)(kb * 128 + kg * 16) * 4096 + n0 + 4 * ng; pitch = 4096;
            dst = wguT + (size_t)e * 4096 * 2048 + (size_t)(drow + 4 * ng) * 2048 + kb * 128 + kg * 16; }
        else { const int i2 = it - 65536, e = i2 >> 10, rr = i2 & 1023, kb = rr >> 6, nb = rr & 63, n0 = nb * 32;
            s = wd + (size_t)e * 2048 * 2048 + (size_t)(kb * 128 + kg * 16) * 2048 + n0 + 4 * ng; pitch = 2048;
            dst = wdT + (size_t)e * 2048 * 2048 + (size_t)(n0 + 4 * ng) * 2048 + kb * 128 + kg * 16; }
#pragma unroll
        for (int i = 0; i < 16; ++i) v[i] = __builtin_nontemporal_load((const f32x4*)(s + (size_t)i * pitch));
    }
    __device__ __forceinline__ void store_item(const f32x4 (&v)[16], unsigned char* dst) const {
#pragma unroll
        for (int c = 0; c < 4; ++c) { u32x4 o;
            o.x = pk4_fp8(v[0][c] * 64.f, v[1][c] * 64.f, v[2][c] * 64.f, v[3][c] * 64.f); o.y = pk4_fp8(v[4][c] * 64.f, v[5][c] * 64.f, v[6][c] * 64.f, v[7][c] * 64.f);
            o.z = pk4_fp8(v[8][c] * 64.f, v[9][c] * 64.f, v[10][c] * 64.f, v[11][c] * 64.f); o.w = pk4_fp8(v[12][c] * 64.f, v[13][c] * 64.f, v[14][c] * 64.f, v[15][c] * 64.f);
            *(u32x4*)(dst + (size_t)c * 2048) = o; }
    }
    template <class IT> __device__ __forceinline__ void run_range(int j, const int jend, int lane, IT item) const {
        if (j >= jend) return;
        f32x4 v0[16], v1[16], v2[16]; unsigned char *d0 = nullptr, *d1 = nullptr, *d2 = nullptr;
        load_item(item(j), lane, v0, d0); if (j + 1 < jend) load_item(item(j + 1), lane, v1, d1); if (j + 2 < jend) load_item(item(j + 2), lane, v2, d2);
        for (; j < jend; j += 3) {
            store_item(v0, d0); if (j + 3 < jend) load_item(item(j + 3), lane, v0, d0);
            if (j + 1 < jend) { store_item(v1, d1); if (j + 4 < jend) load_item(item(j + 4), lane, v1, d1); }
            if (j + 2 < jend) { store_item(v2, d2); if (j + 5 < jend) load_item(item(j + 5), lane, v2, d2); }
        }
    }
    __device__ __forceinline__ void run(int nitems, int lane) const {
        const int j = *cnt; const int jown = (nw == 2048) ? CONV_P1_PER_WAVE : (CONV_ITEMS - gw + nw - 1) / nw; const int jend = (j + nitems < jown) ? j + nitems : jown;
        if (j >= jend) return;
        const int g_ = gw, n_ = nw; run_range(j, jend, lane, [g_, n_](int jj) { return g_ + n_ * jj; });
        *cnt = jend;
    }
};
struct ConvPool {
    ConvHook h; int first, n;
    __device__ __forceinline__ void run(int, int lane) const { const int f_ = first; h.run_range(0, n, lane, [f_](int jj) { return f_ + jj; }); }
};
struct NoHook { __device__ __forceinline__ void run(int, int) const {} };

namespace pg8 {
constexpr int BM = 256, BK = 64, HALF = 128, HTB = HALF * BK * 2, STAGE_BYTES = 8 * HTB, NXCD = 8, WGM = 8;
__host__ __device__ __forceinline__ int lds_byte(int r, int c) { const int st = (r >> 4) * 2 + (c >> 5), rr = r & 15, cc = c & 31, ob = rr * 64 + cc * 2; return st * 1024 + (ob ^ (((ob >> 9) & 1) << 5)); }
__host__ __device__ __forceinline__ void stage_rc(int b, int& R, int& C) { const int st = b / 1024, sb = b % 1024, swz = sb ^ (((sb >> 9) & 1) << 5); R = (st >> 1) * 16 + swz / 64; C = (st & 1) * 32 + (swz % 64) / 2; }
__host__ __device__ __forceinline__ int perm32(int rho) { const int n = rho >> 4, i = rho & 15; return 8 * (i >> 2) + 4 * n + (i & 3); }

struct Unit { const char* a; const char* b; int nt; int pm, pn, z; };
struct Gemm { unsigned lda, ldb; };

__device__ __forceinline__ void tile_order(int L, int nM, int nN, int& pm, int& pn) {
    const int nwg = nM * nN; int wgid = L;
    { const int q = nwg / NXCD, r = nwg % NXCD, xcd = wgid % NXCD, off = wgid / NXCD; wgid = (xcd < r ? xcd * (q + 1) : r * (q + 1) + (xcd - r) * q) + off; }
    const int nig = WGM * nN, gid = wgid / nig, fm = gid * WGM, gsz = (nM - fm) < WGM ? (nM - fm) : WGM;
    pm = fm + ((wgid % nig) % gsz); pn = (wgid % nig) / gsz;
}

template <class Epi, class Sched, class Hook = NoHook, bool FP8 = false, bool ALIGN_EPI = true, bool SP2 = true>
__device__ __forceinline__ void gemm_phase(LAS unsigned char* lds, const int wid, const Gemm g, const Sched& S, const Epi& E, const Hook& H = Hook(), const int hook_rounds = 0, const int hook_slot = -1) {
    const int lane = lane_id(), tid = wid * 64 + lane, wr = wid >> 2, wc = wid & 3;
    unsigned voffA[2], voffB[2];
#pragma unroll
    for (int i = 0; i < 2; ++i) { int R, C; stage_rc(tid * 16 + i * 8192, R, C); const int Rb = Epi::PERM ? ((R & ~31) + perm32(R & 31)) : R;
        voffA[i] = (unsigned)R * g.lda + (unsigned)C * 2u; voffB[i] = (unsigned)Rb * g.ldb + (unsigned)C * 2u; }
    const size_t kstep = (size_t)(BK * 2);
    const size_t hstepA = (size_t)HALF * g.lda, hstepB = (size_t)HALF * g.ldb;
    const unsigned ldsw = (unsigned)wid * 1024u;
    const unsigned ldsbase = (unsigned)(size_t)lds;
    const int aoff = lds_byte(wr * 64 + (lane & 15), (lane >> 4) * 8), boff = lds_byte(wc * 32 + (lane & 15), (lane >> 4) * 8);
#define PG8_SA(b, h) (((b) * 2 + (h)) * HTB)
#define PG8_SB(b, h) ((4 + (b) * 2 + (h)) * HTB)
#define PG8_STAGE(bufoff, gbase, voff) do { unsigned _keep; \
        asm volatile("s_mov_b32 %0, m0\n\ts_mov_b32 m0, %3\n\ts_nop 0\n\tglobal_load_lds_dwordx4 %1, %4\n\ts_bitset1_b32 m0, 13\n\ts_nop 0\n\tglobal_load_lds_dwordx4 %2, %4\n\ts_mov_b32 m0, %0" \
            : "=&s"(_keep) : "v"((voff)[0]), "v"((voff)[1]), "s"(ldsbase + (unsigned)(bufoff) + ldsw), "s"(uniform_ptr((const char*)(gbase))) : "memory"); } while (0)
#define PG8_LDA(dst, b, h) do { _Pragma("unroll") for (int m = 0; m < 4; ++m) _Pragma("unroll") for (int k = 0; k < 2; ++k) dst[m][k] = *(const LAS bf16x8*)(lds + PG8_SA(b, h) + aoff + m * 2048 + k * 1024); } while (0)
#define PG8_LDB(dst, b, h) do { _Pragma("unroll") for (int n = 0; n < 2; ++n) _Pragma("unroll") for (int k = 0; k < 2; ++k) dst[n][k] = *(const LAS bf16x8*)(lds + PG8_SB(b, h) + boff + n * 2048 + k * 1024); } while (0)
#define PG8_MMA(ai, bj, At, Bt) do { __builtin_amdgcn_s_setprio(1); _Pragma("unroll") for (int m = 0; m < 4; ++m) _Pragma("unroll") for (int n = 0; n < 2; ++n) { \
        if constexpr (FP8) { const i32x8 _b8 = __builtin_shufflevector(__builtin_bit_cast(i32x4, Bt[n][0]), __builtin_bit_cast(i32x4, Bt[n][1]), 0, 1, 2, 3, 4, 5, 6, 7); \
                const i32x8 _a8 = __builtin_shufflevector(__builtin_bit_cast(i32x4, At[m][0]), __builtin_bit_cast(i32x4, At[m][1]), 0, 1, 2, 3, 4, 5, 6, 7); \
                asm volatile("v_mfma_scale_f32_16x16x128_f8f6f4 %0, %1, %2, %0, %3, %4 op_sel_hi:[0,0,0]" : "+v"(acc[ai][bj][m][n]) : "v"(_b8), "v"(_a8), "v"(sc_w), "v"(sc_x)); }   \
        else { _Pragma("unroll") for (int k = 0; k < 2; ++k) acc[ai][bj][m][n] = __builtin_amdgcn_mfma_f32_16x16x32_bf16(Bt[n][k], At[m][k], acc[ai][bj][m][n], 0, 0, 0); } } __builtin_amdgcn_s_setprio(0); } while (0)
#define PG8_WAIT_V(n) asm volatile("s_waitcnt vmcnt(" #n ")" ::: "memory")
#define PG8_WAIT_L(n) asm volatile("s_waitcnt lgkmcnt(" #n ")" ::: "memory")
#define PG8_BAR __builtin_amdgcn_s_barrier()
#define PG8_SCHED __builtin_amdgcn_sched_barrier(0)
    const int sc_w = 0x79797979, sc_x = 0x7f7f7f7f; (void)sc_w; (void)sc_x;
    Unit cur, nxt; int ui = 0;
    if (!S.next(0, cur)) return;
    f32x4 acc[2][2][4][2];
#pragma unroll
    for (int a = 0; a < 2; ++a)
#pragma unroll
        for (int b = 0; b < 2; ++b)
#pragma unroll
            for (int m = 0; m < 4; ++m)
#pragma unroll
                for (int n = 0; n < 2; ++n) acc[a][b][m][n] = (f32x4){0.f, 0.f, 0.f, 0.f};
    bf16x8 At[4][2], B0[2][2], B1[2][2];
    const char* cA = cur.a; const char* cB = cur.b;
    S.ready(cur, wid);
    if constexpr (SP2) {
        PG8_STAGE(PG8_SB(0, 0), cB, voffB); PG8_STAGE(PG8_SB(0, 1), cB + hstepB, voffB); PG8_STAGE(PG8_SA(0, 0), cA, voffA); PG8_STAGE(PG8_SA(0, 1), cA + hstepA, voffA);
        if (wr == 1) PG8_BAR;
        PG8_WAIT_V(2); PG8_BAR;
        PG8_STAGE(PG8_SB(1, 0), cB + kstep, voffB); PG8_STAGE(PG8_SA(1, 0), cA + kstep, voffA); PG8_STAGE(PG8_SB(1, 1), cB + hstepB + kstep, voffB);
        PG8_WAIT_V(6); PG8_BAR;
    } else {
        PG8_STAGE(PG8_SB(0, 0), cB, voffB); PG8_STAGE(PG8_SA(0, 0), cA, voffA); PG8_STAGE(PG8_SB(0, 1), cB + hstepB, voffB); PG8_STAGE(PG8_SA(0, 1), cA + hstepA, voffA);
        if (wr == 1) PG8_BAR;
        PG8_WAIT_V(4); PG8_BAR;
        PG8_STAGE(PG8_SB(1, 0), cB + kstep, voffB); PG8_STAGE(PG8_SA(1, 0), cA + kstep, voffA); PG8_STAGE(PG8_SB(1, 1), cB + hstepB + kstep, voffB);
        PG8_WAIT_V(6); PG8_BAR;
    }
    for (;;) {
        const bool has_next = S.next(ui + 1, nxt);
        const char* nA = has_next ? nxt.a : cA; const char* nB = has_next ? nxt.b : cB;
        const int nt = cur.nt;
#pragma unroll 1
        for (int t = 0; t < nt; t += 2) {
            const bool last = (t == nt - 2);
            if (last && has_next) S.ready(nxt, wid);
            const char* a1 = cA + (size_t)(t + 1) * kstep;
            const char* a2 = last ? nA : cA + (size_t)(t + 2) * kstep; const char* b2 = last ? nB : cB + (size_t)(t + 2) * kstep;
            const char* a3 = a2 + kstep; const char* b3 = b2 + kstep;
            if constexpr (SP2) {
            PG8_LDB(B0, 0, 0); PG8_LDB(B1, 0, 1); PG8_SCHED; PG8_LDA(At, 0, 0); PG8_STAGE(PG8_SA(1, 1), a1 + hstepA, voffA);
            PG8_WAIT_V(8); PG8_WAIT_L(0); PG8_BAR; PG8_MMA(0, 0, At, B0); PG8_MMA(0, 1, At, B1); PG8_BAR; PG8_SCHED;
            PG8_LDA(At, 0, 1); PG8_STAGE(PG8_SB(0, 0), b2, voffB); PG8_STAGE(PG8_SB(0, 1), b2 + hstepB, voffB); PG8_STAGE(PG8_SA(0, 0), a2, voffA);
            PG8_WAIT_V(8); PG8_WAIT_L(0); PG8_BAR; PG8_MMA(1, 0, At, B0); PG8_MMA(1, 1, At, B1); PG8_BAR; PG8_SCHED;
            PG8_LDB(B0, 1, 0); PG8_LDB(B1, 1, 1); PG8_SCHED; PG8_LDA(At, 1, 0); PG8_STAGE(PG8_SA(0, 1), a2 + hstepA, voffA);
            PG8_WAIT_V(8); PG8_WAIT_L(0); PG8_BAR; PG8_MMA(0, 0, At, B0); PG8_MMA(0, 1, At, B1); PG8_BAR; PG8_SCHED;
            PG8_LDA(At, 1, 1); PG8_STAGE(PG8_SB(1, 0), b3, voffB); PG8_STAGE(PG8_SB(1, 1), b3 + hstepB, voffB); PG8_STAGE(PG8_SA(1, 0), a3, voffA);
            PG8_WAIT_V(8); PG8_WAIT_L(0); PG8_BAR; PG8_MMA(1, 0, At, B0); PG8_MMA(1, 1, At, B1); PG8_BAR; PG8_SCHED;
            } else {
            PG8_LDB(B0, 0, 0); PG8_SCHED; PG8_LDA(At, 0, 0); PG8_STAGE(PG8_SA(1, 1), a1 + hstepA, voffA);
            PG8_WAIT_L(8); PG8_BAR; PG8_WAIT_L(0); PG8_MMA(0, 0, At, B0); PG8_BAR; PG8_SCHED;
            PG8_LDB(B1, 0, 1); PG8_STAGE(PG8_SB(0, 0), b2, voffB);
            PG8_BAR; PG8_WAIT_L(0); PG8_MMA(0, 1, At, B1); PG8_BAR;
            PG8_LDA(At, 0, 1); PG8_STAGE(PG8_SA(0, 0), a2, voffA);
            PG8_BAR; PG8_WAIT_L(0); PG8_MMA(1, 0, At, B0); PG8_BAR; PG8_SCHED;
            PG8_STAGE(PG8_SB(0, 1), b2 + hstepB, voffB);
            PG8_WAIT_V(6); PG8_BAR; PG8_MMA(1, 1, At, B1); PG8_BAR;
            PG8_LDB(B0, 1, 0); PG8_SCHED; PG8_LDA(At, 1, 0); PG8_STAGE(PG8_SA(0, 1), a2 + hstepA, voffA);
            PG8_WAIT_L(8); PG8_BAR; PG8_WAIT_L(0); PG8_MMA(0, 0, At, B0); PG8_BAR; PG8_SCHED;
            PG8_LDB(B1, 1, 1); PG8_STAGE(PG8_SB(1, 0), b3, voffB);
            PG8_BAR; PG8_WAIT_L(0); PG8_MMA(0, 1, At, B1); PG8_BAR;
            PG8_LDA(At, 1, 1); PG8_STAGE(PG8_SA(1, 0), a3, voffA);
            PG8_BAR; PG8_WAIT_L(0); PG8_MMA(1, 0, At, B0); PG8_BAR; PG8_SCHED;
            PG8_STAGE(PG8_SB(1, 1), b3 + hstepB, voffB);
            PG8_WAIT_V(6); PG8_BAR; PG8_MMA(1, 1, At, B1); PG8_BAR;
            }
        }
        if constexpr (ALIGN_EPI) { if (wr == 0) PG8_BAR; }
        if constexpr (FP8) { asm volatile("s_nop 15\n\ts_nop 15"); }
        const int ln_o = lane_id();
        const bool keep = E(acc, cur, wr, wc, ln_o & 15, ln_o >> 4);
        if (!keep) {
            if (hook_slot == -1 || ui == hook_slot || (hook_slot == -2 && !has_next)) H.run(hook_rounds, ln_o);
#pragma unroll
            for (int a = 0; a < 2; ++a)
#pragma unroll
                for (int b = 0; b < 2; ++b)
#pragma unroll
                    for (int m = 0; m < 4; ++m)
#pragma unroll
                        for (int n = 0; n < 2; ++n) acc[a][b][m][n] = (f32x4){0.f, 0.f, 0.f, 0.f};
        }
        if (!has_next) break;
        cur = nxt; cA = nA; cB = nB; ++ui;
        if constexpr (ALIGN_EPI) { if (wr == 1) PG8_BAR; }
    }
    PG8_WAIT_V(0);
    if constexpr (!ALIGN_EPI) { if (wr == 0) PG8_BAR; }
    PG8_BAR;
#undef PG8_SA
#undef PG8_SB
#undef PG8_STAGE
#undef PG8_LDA
#undef PG8_LDB
#undef PG8_MMA
#undef PG8_WAIT_V
#undef PG8_WAIT_L
#undef PG8_BAR
#undef PG8_SCHED
}

__device__ __forceinline__ f32x2 gelu_pk(f32x2 v) {
    const f32x2 av = __builtin_elementwise_abs(v), d = av * 0.2316418882f + 1.0f;
    f32x2 t; t.x = __builtin_amdgcn_rcpf(d.x); t.y = __builtin_amdgcn_rcpf(d.y);
    f32x2 q = t * 0.5307027145f + (-0.7265760135f); q = q * t + 0.7107068705f; q = q * t + (-0.142248368f); q = q * t + 0.127414796f; q = q * t;
    const f32x2 s = (v * v) * (-0.72134752044f);
    f32x2 e; e.x = __builtin_amdgcn_exp2f(s.x); e.y = __builtin_amdgcn_exp2f(s.y);
    const f32x2 m = v * (q * e), r = v - m;
    f32x2 o; o.x = v.x < 0.f ? m.x : r.x; o.y = v.y < 0.f ? m.y : r.y; return o;
}
}
using pg8::Unit;

struct SchedGrid {
    const char* A; const char* B; unsigned lda, ldb; int nM, nN, G, c, nt, pn_off = 0;
    __device__ __forceinline__ void ready(const Unit&, int) const {}
    __device__ __forceinline__ bool next(int i, Unit& u) const {
        const int L = i * G + c; if (L >= nM * nN) return false;
        int pm, pn; pg8::tile_order(L, nM, nN, pm, pn);
        u.a = A + (size_t)pm * 256 * lda; u.b = B + (size_t)pn * 256 * ldb; u.nt = nt; u.pm = pm; u.pn = pn + pn_off; u.z = 0; return true;
    }
};
struct SchedMerge {
    const char* A; const char* B; int G, c;
    __device__ __forceinline__ void ready(const Unit&, int) const {}
    __device__ __forceinline__ bool next(int i, Unit& u) const {
        const int L = (i >> 1) * G + c, half = i & 1; if (L >= 32 * 8) return false;
        int pm, pn; pg8::tile_order(L, 32, 8, pm, pn);
        u.a = A + (size_t)pm * 256 * 8192 + half * 4096; u.b = B + (size_t)pn * 256 * 8192 + half * 4096; u.nt = 32; u.pm = pm; u.pn = pn; u.z = half; return true;
    }
};
struct SchedSgu {
    const char* Wbd; const char* VgT; int G, c;
    __device__ __forceinline__ void ready(const Unit&, int) const {}
    __device__ __forceinline__ bool next(int i, Unit& u) const {
        const int L = i * G + c; if (L >= 256) return false;
        const int bp = L >> 3, g = L & 7, b = bp >> 3, pair = bp & 7;
        u.a = Wbd + (size_t)g * 256 * 512; u.b = VgT + ((size_t)(b * 2048 + g * 256) * 2048 + pair * 256) * 2; u.nt = 4; u.pm = bp; u.pn = g; u.z = 0; return true;
    }
};
struct SchedQK {
    const char* QKc; int G, c;
    __device__ __forceinline__ void ready(const Unit&, int) const {}
    __device__ __forceinline__ bool next(int i, Unit& u) const {
        int bh, tri;
        if ((G & 7) == 0) { const int x = c & 7, q = c >> 3, W = G >> 3; const int L = i * W + q; if (L >= 72) return false; bh = x + 8 * (L / 36); tri = L % 36; }
        else { const int L = i * G + c; if (L >= 16 * 36) return false; bh = L / 36; tri = L % 36; }
        int pm = 0; while ((pm + 1) * (pm + 2) / 2 <= tri) ++pm; const int pn = tri - pm * (pm + 1) / 2;
        const int b = bh >> 2, h = bh & 3;
        u.a = QKc + ((size_t)(b * 2048 + pm * 256) * 4096 + h * 512) * 2; u.b = QKc + ((size_t)(b * 2048 + pn * 256) * 4096 + 2048 + h * 512) * 2;
        u.nt = 8; u.pm = pm; u.pn = pn; u.z = bh; return true;
    }
};
struct SchedPV {
    const char* P; const char* VmT; int G, c;
    __device__ __forceinline__ void ready(const Unit&, int) const {}
    __device__ __forceinline__ bool next(int i, Unit& u) const {
        const int L = i * G + c; if (L >= 256) return false;
        const int bh = L & 15, r = L >> 4, pm = 7 - (r >> 1), pn = r & 1, b = bh >> 2, h = bh & 3;
        u.a = P + ((size_t)(bh * 2048 + pm * 256) * 2048) * 2; u.b = VmT + ((size_t)(b * 2048 + h * 512 + pn * 256) * 2048) * 2;
        u.nt = 4 * (pm + 1); u.pm = pm; u.pn = pn; u.z = bh; return true;
    }
};
struct SchedMoe {
    const char* A; const char* B; volatile LAS int* tab; int NT; size_t bexp; int G, c;
    __device__ __forceinline__ void ready(const Unit&, int) const {}
    __device__ __forceinline__ bool next(int i, Unit& u) const {
        const int NG = (G & 7) ? 1 : 8, x = c % NG, q = c / NG, W = G / NG, ne = 32 / NG;
        const int L = i * W + q; const int total = __builtin_amdgcn_readfirstlane(tab[ne]); if (L >= total) return false;
        int j = 0; while (L >= __builtin_amdgcn_readfirstlane(tab[j + 1])) ++j;
        const int e = x + NG * j, r = L - __builtin_amdgcn_readfirstlane(tab[j]), tiles = __builtin_amdgcn_readfirstlane(tab[40 + j]);
        const int ti = r % tiles, pn = r / tiles;
        u.a = A + ((size_t)e * CAP + (size_t)ti * 256) * 2048; u.b = B + (size_t)e * bexp + (size_t)pn * 256 * 2048; u.nt = 16; u.pm = ti; u.pn = pn; u.z = e; return true;
    }
};

struct SchedMoe2 {
    const char *Xs, *Ha, *Wgu, *Wd; volatile LAS int* tab; int G, c; unsigned* hcnt; unsigned* tmo; int kind;
    __device__ __forceinline__ bool next(int i, Unit& u) const {
        const int NG = (G & 7) ? 1 : 8, q = c / NG, W = G / NG, ne = 32 / NG;
        const int t10 = __builtin_amdgcn_readfirstlane(tab[ne]); const int n1 = (t10 > q) ? (t10 - q + W - 1) / W : 0;
        const int L = (kind == 0) ? i * W + q : (i + n1) * W + q; if (kind == 0 && L >= t10) return false;
        if (L < t10) { int j = 0; while (L >= __builtin_amdgcn_readfirstlane(tab[j + 1])) ++j;
            const int e = __builtin_amdgcn_readfirstlane(tab[(NG == 8 ? 48 : 80) + j]), r = L - __builtin_amdgcn_readfirstlane(tab[j]), tiles = __builtin_amdgcn_readfirstlane(tab[40 + j]); const int ti = r % tiles, pn = r / tiles;
            u.a = uniform_ptr(Xs + ((size_t)e * CAP + (size_t)ti * 256) * 2048); u.b = uniform_ptr(Wgu + (size_t)e * ((size_t)4096 * 2048) + (size_t)pn * 256 * 2048); u.nt = 16; u.pm = ti; u.pn = pn; u.z = e; return true; }
        const int L2 = L - t10; if (L2 >= (t10 >> 1)) return false;
        int j = 0; while (L2 >= (__builtin_amdgcn_readfirstlane(tab[j + 1]) >> 1)) ++j;
        const int e = __builtin_amdgcn_readfirstlane(tab[(NG == 8 ? 48 : 80) + j]), r = L2 - (__builtin_amdgcn_readfirstlane(tab[j]) >> 1), tiles = __builtin_amdgcn_readfirstlane(tab[40 + j]); const int ti = r % tiles, pn = r / tiles;
        u.a = uniform_ptr(Ha + ((size_t)e * CAP + (size_t)ti * 256) * 2048); u.b = uniform_ptr(Wd + (size_t)e * ((size_t)2048 * 2048) + (size_t)pn * 256 * 2048); u.nt = 16; u.pm = ti; u.pn = pn; u.z = e + 32; return true;
    }
    __device__ __forceinline__ void ready(const Unit& u, int wid) const {
        if (u.z < 32 || hcnt == nullptr) return;
        if (wid == 0) { unsigned* cp = hcnt + (size_t)((u.z - 32) * 32 + u.pm) * 16; unsigned spins = 0;
            while ((unsigned)__builtin_amdgcn_readfirstlane((int)__hip_atomic_load(cp, __ATOMIC_RELAXED, __HIP_MEMORY_SCOPE_AGENT)) < 128u) {
                if ((++spins & 63u) == 0u && __builtin_amdgcn_readfirstlane((int)__hip_atomic_load(tmo, __ATOMIC_RELAXED, __HIP_MEMORY_SCOPE_AGENT)) != 0) break;
                if (spins > (1u << 20)) { __hip_atomic_store(tmo, 1u, __ATOMIC_RELAXED, __HIP_MEMORY_SCOPE_AGENT); break; }
                __builtin_amdgcn_s_sleep(2); }
            __builtin_amdgcn_fence(__ATOMIC_ACQUIRE, "agent");
            asm volatile("s_waitcnt vmcnt(0)" ::: "memory"); }
        asm volatile("" ::: "memory"); __builtin_amdgcn_s_barrier(); asm volatile("" ::: "memory");
    }
};

using pg8::gelu_pk;
#define EPI_ARGS f32x4 (&acc)[2][2][4][2], const Unit& u, int wr, int wc, int fr, int fq
struct EpiIn {
    static constexpr bool PERM = true;
    const float* b_in; unsigned char* wsb;
    __device__ __forceinline__ bool operator()(EPI_ARGS) const {
        GAS unsigned char* w_ = (GAS unsigned char*)wsb; asm volatile("" : "+s"(w_));
        bf16* const Ug = (bf16*)(GAS bf16*)(w_ + WS_UG); bf16* const VgT = (bf16*)(GAS bf16*)(w_ + WS_VGT); bf16* const QKr = (bf16*)(GAS bf16*)(w_ + WS_QKR); bf16* const VmT = (bf16*)(GAS bf16*)(w_ + WS_VMT);
        bf16* const Og = (bf16*)(GAS bf16*)(w_ + WS_OG); bf16* const Ga = (bf16*)(GAS bf16*)(w_ + WS_GA); float* const vpart = (float*)(GAS float*)(w_ + WS_VPART);
        const int pn = u.pn; const int row0 = u.pm * 256 + wr * 64 + fr; const int cw = wc * 32 + 8 * fq;
        const int ncol0 = pn * 256 + cw; const int bcol0 = ncol0 + (ncol0 >= 12288 ? 8 : 0);
        f32x4 bv[2][2];
#pragma unroll
        for (int bj = 0; bj < 2; ++bj)
#pragma unroll
            for (int n = 0; n < 2; ++n) {
                const float* bp = b_in + bcol0 + bj * 128 + 4 * n; bv[bj][n] = (f32x4){bp[0], bp[1], bp[2], bp[3]}; }
        __builtin_amdgcn_s_waitcnt(0x0F70);
        if (pn < 8 || (pn >= 16 && pn < 32) || pn >= 40) {
            bf16* base; int ldc, colt; int act;
            if (pn < 8) { base = Ug; ldc = 2048; colt = pn * 256; act = 1; }
            else if (pn < 32) { base = QKr; ldc = 4096; colt = (pn - 16) * 256; act = 0; }
            else if (pn < 48) { base = Og; ldc = 2048; colt = (pn - 40) * 256; act = 2; }
            else { base = Ga; ldc = 2048; colt = (pn - 48) * 256; act = 2; if (pn >= 56) { base += (size_t)T * 2048; colt -= 2048; } }
#pragma unroll
            for (int ai = 0; ai < 2; ++ai)
#pragma unroll
                for (int m = 0; m < 4; ++m) { bf16* rowp = base + (size_t)(row0 + ai * 128 + m * 16) * ldc + colt + cw;
#pragma unroll
                    for (int bj = 0; bj < 2; ++bj) { f32x4 v0 = acc[ai][bj][m][0] + bv[bj][0], v1 = acc[ai][bj][m][1] + bv[bj][1];
                        if (act == 1) { f32x2 a = gelu_pk((f32x2){v0[0], v0[1]}), b = gelu_pk((f32x2){v0[2], v0[3]}), c = gelu_pk((f32x2){v1[0], v1[1]}), d = gelu_pk((f32x2){v1[2], v1[3]});
                            v0 = (f32x4){a.x, a.y, b.x, b.y}; v1 = (f32x4){c.x, c.y, d.x, d.y}; }
                        else if (act == 2) {
#pragma unroll
                            for (int j = 0; j < 4; ++j) { v0[j] = sigmoidf_(v0[j]); v1[j] = sigmoidf_(v1[j]); } }
                        u32x4 w; w.x = cvt_pk_bf16(v0[0], v0[1]); w.y = cvt_pk_bf16(v0[2], v0[3]); w.z = cvt_pk_bf16(v1[0], v1[1]); w.w = cvt_pk_bf16(v1[2], v1[3]);
                        *(u32x4*)(rowp + bj * 128) = w; } }
        } else {
            const bool isv = pn < 16; bf16* base = isv ? VgT : VmT; const int colt = (isv ? pn - 8 : pn - 32) * 256;
#pragma unroll
            for (int ai = 0; ai < 2; ++ai)
#pragma unroll
                for (int m = 0; m < 4; ++m) { const int row = row0 + ai * 128 + m * 16; const int b = row >> 11, s = row & 2047; float sm = 0.f, sq = 0.f;
#pragma unroll
                    for (int bj = 0; bj < 2; ++bj) { f32x4 v0 = acc[ai][bj][m][0] + bv[bj][0], v1 = acc[ai][bj][m][1] + bv[bj][1];
                        if (isv) { f32x2 a = gelu_pk((f32x2){v0[0], v0[1]}), bb = gelu_pk((f32x2){v0[2], v0[3]}), c = gelu_pk((f32x2){v1[0], v1[1]}), d = gelu_pk((f32x2){v1[2], v1[3]});
                            v0 = (f32x4){a.x, a.y, bb.x, bb.y}; v1 = (f32x4){c.x, c.y, d.x, d.y};
#pragma unroll
                            for (int j = 0; j < 4; ++j) { sm += v0[j] + v1[j]; sq += v0[j] * v0[j] + v1[j] * v1[j]; } }
                        bf16* cp = base + ((size_t)(b * 2048 + colt + bj * 128 + cw) * 2048 + s);
#pragma unroll
                        for (int j = 0; j < 4; ++j) { cp[(size_t)j * 2048] = (bf16)f2bf(v0[j]); cp[(size_t)(4 + j) * 2048] = (bf16)f2bf(v1[j]); } }
                    if (isv) { sm += __shfl_xor(sm, 16); sm += __shfl_xor(sm, 32); sq += __shfl_xor(sq, 16); sq += __shfl_xor(sq, 32);
                        if (fq == 0) { float* vp = vpart + (size_t)row * 64 + (pn - 8) * 4 + wc; vp[0] = sm; vp[32] = sq; } } }
        }
        return false;
    }
};
struct EpiSgu {
    static constexpr bool PERM = true;
    const bf16* Ug; const float* b_sgu; bf16* Y;
    __device__ __forceinline__ bool operator()(EPI_ARGS) const {
        const int g = u.pn; const int rt0 = wr * 64 + fr; const int cw = wc * 32 + 8 * fq;
#pragma unroll
        for (int ai = 0; ai < 2; ++ai) {
            u32x4 uu[4][2]; float bs[4];
#pragma unroll
            for (int m = 0; m < 4; ++m) { const int rt = rt0 + ai * 128 + m * 16; const size_t row = (size_t)u.pm * 256 + rt; bs[m] = b_sgu[g * 128 + (rt & 127)];
#pragma unroll
                for (int bj = 0; bj < 2; ++bj) uu[m][bj] = *(const u32x4*)(Ug + row * 2048 + g * 256 + bj * 128 + cw); }
#pragma unroll
            for (int m = 0; m < 4; ++m) { const int rt = rt0 + ai * 128 + m * 16; const size_t row = (size_t)u.pm * 256 + rt;
#pragma unroll
                for (int bj = 0; bj < 2; ++bj) { const int col = g * 256 + bj * 128 + cw; const u32x4 q = uu[m][bj];
                    const f32x4 v0 = acc[ai][bj][m][0] + bs[m], v1 = acc[ai][bj][m][1] + bs[m];
                    u32x4 w; w.x = cvt_pk_bf16(bflo(q.x) * v0[0], bfhi(q.x) * v0[1]); w.y = cvt_pk_bf16(bflo(q.y) * v0[2], bfhi(q.y) * v0[3]);
                    w.z = cvt_pk_bf16(bflo(q.z) * v1[0], bfhi(q.z) * v1[1]); w.w = cvt_pk_bf16(bflo(q.w) * v1[2], bfhi(q.w) * v1[3]);
                    *(u32x4*)(Y + row * 4096 + col) = w; } }
            asm volatile("" ::: "memory"); }
        return false;
    }
};
struct EpiQK {
    static constexpr bool PERM = true;
    const float *aS, *Mt; bf16* P; float* denp;
    __device__ __forceinline__ bool operator()(EPI_ARGS) const {
        const int bh = u.z; const int cw = wc * 32 + 8 * fq; const bool diag = (u.pm == u.pn);
        float av[2][8];
#pragma unroll
        for (int bj = 0; bj < 2; ++bj) { const float* ap = aS + bh * 2048 + u.pn * 256 + bj * 128 + cw;
#pragma unroll
            for (int j = 0; j < 8; ++j) av[bj][j] = ap[j] * 1.44269504089f; }
        const int rt0 = wr * 64 + fr;
        const float* mtp = Mt + bh * 2048 + u.pm * 256 + rt0; float* dpp = denp + (size_t)(bh * 2048 + u.pm * 256 + rt0) * 32 + u.pn * 4 + wc;
        bf16* prow = P + ((size_t)(bh * 2048 + u.pm * 256 + rt0) * 2048 + u.pn * 256 + cw);
        float mtv[8];
#pragma unroll
        for (int r8 = 0; r8 < 8; ++r8) mtv[r8] = mtp[(r8 >> 2) * 128 + (r8 & 3) * 16] * 1.44269504089f;
#pragma unroll
        for (int ai = 0; ai < 2; ++ai)
#pragma unroll
            for (int m = 0; m < 4; ++m) { const int ro = ai * 128 + m * 16; const float mt = mtv[ai * 4 + m]; float rs = 0.f;
#pragma unroll
                for (int bj = 0; bj < 2; ++bj) { float o[8];
                    const float lim = diag ? (float)(rt0 + ro - bj * 128 - cw + 1) : 1.0e9f;
#pragma unroll
                    for (int j = 0; j < 8; ++j) { const float sv = (j < 4) ? acc[ai][bj][m][0][j] : acc[ai][bj][m][1][j - 4];
                        const float w = __builtin_amdgcn_exp2f(fminf(av[bj][j] - mt, 0.f)); const float f = __builtin_amdgcn_fmed3f(lim - (float)j, 0.f, 1.f);
                        o[j] = sv * (w * f); rs += o[j]; }
                    u32x4 w4; w4.x = cvt_pk_bf16(o[0], o[1]); w4.y = cvt_pk_bf16(o[2], o[3]); w4.z = cvt_pk_bf16(o[4], o[5]); w4.w = cvt_pk_bf16(o[6], o[7]);
                    *(u32x4*)(prow + (size_t)ro * 2048 + bj * 128) = w4; }
                rs += __shfl_xor(rs, 16); rs += __shfl_xor(rs, 32);
                if (fq == 0) dpp[(size_t)ro * 32] = rs;
                asm volatile("" ::: "memory"); }
        return false;
    }
};
struct EpiPV {
    static constexpr bool PERM = true;
    const float *denp, *Bm; bf16* Hm; float* ssqp;
    __device__ __forceinline__ bool operator()(EPI_ARGS) const {
        const int bh = u.z, b = bh >> 2, h = bh & 3; const int cw = wc * 32 + 8 * fq; const int t0 = u.pm * 256 + wr * 64 + fr;
        float dsum[8], bm[8];
#pragma unroll
        for (int r8 = 0; r8 < 8; ++r8) { dsum[r8] = 0.f; bm[r8] = Bm[bh * 2048 + t0 + (r8 >> 2) * 128 + (r8 & 3) * 16]; }
        for (int q = 0; q <= u.pm; ++q) { f32x4 d4[8];
#pragma unroll
            for (int r8 = 0; r8 < 8; ++r8) d4[r8] = *(const f32x4*)(denp + (size_t)(bh * 2048 + t0 + (r8 >> 2) * 128 + (r8 & 3) * 16) * 32 + q * 4);
#pragma unroll
            for (int r8 = 0; r8 < 8; ++r8) dsum[r8] += (d4[r8].x + d4[r8].y) + (d4[r8].z + d4[r8].w); }
#pragma unroll
        for (int ai = 0; ai < 2; ++ai)
#pragma unroll
            for (int m = 0; m < 4; ++m) { const int t = t0 + ai * 128 + m * 16; const int tok = b * 2048 + t;
                const float dn = fabsf(dsum[ai * 4 + m]), lo = fast_exp(-bm[ai * 4 + m]); const float inv = 1.0f / fmaxf(dn, lo); float sq = 0.f;
#pragma unroll
                for (int bj = 0; bj < 2; ++bj) { const f32x4 v0 = acc[ai][bj][m][0] * inv, v1 = acc[ai][bj][m][1] * inv;
#pragma unroll
                    for (int j = 0; j < 4; ++j) sq += v0[j] * v0[j] + v1[j] * v1[j];
                    u32x4 w; w.x = cvt_pk_bf16(v0[0], v0[1]); w.y = cvt_pk_bf16(v0[2], v0[3]); w.z = cvt_pk_bf16(v1[0], v1[1]); w.w = cvt_pk_bf16(v1[2], v1[3]);
                    *(u32x4*)(Hm + (size_t)tok * 2048 + h * 512 + u.pn * 256 + bj * 128 + cw) = w; }
                sq += __shfl_xor(sq, 16); sq += __shfl_xor(sq, 32);
                if (fq == 0) ssqp[(size_t)(tok * 4 + h) * 8 + u.pn * 4 + wc] = sq; }
        return false;
    }
};
struct EpiMerge {
    static constexpr bool PERM = true;
    const bf16 *Ga, *Gm; bf16* Mrg;
    __device__ __forceinline__ bool operator()(EPI_ARGS) const {
        const int cw = wc * 32 + 8 * fq; const bool first = (u.z == 0);
#pragma unroll
        for (int ai = 0; ai < 2; ++ai) {
            u32x4 gmv[4][2], gav[4][2];
#pragma unroll
            for (int m = 0; m < 4; ++m) { const size_t row = (size_t)u.pm * 256 + wr * 64 + fr + ai * 128 + m * 16;
#pragma unroll
                for (int bj = 0; bj < 2; ++bj) { const size_t off = row * 2048 + u.pn * 256 + bj * 128 + cw;
                    gmv[m][bj] = *(const u32x4*)(Gm + off); if (first) gav[m][bj] = *(const u32x4*)(Ga + off); else gav[m][bj] = (u32x4){0u, 0u, 0u, 0u}; } }
#pragma unroll
            for (int m = 0; m < 4; ++m) { const size_t row = (size_t)u.pm * 256 + wr * 64 + fr + ai * 128 + m * 16;
#pragma unroll
                for (int bj = 0; bj < 2; ++bj) { const size_t off = row * 2048 + u.pn * 256 + bj * 128 + cw;
                    const u32x4 gm = gmv[m][bj];
                    float s[8] = {bflo(gm.x), bfhi(gm.x), bflo(gm.y), bfhi(gm.y), bflo(gm.z), bfhi(gm.z), bflo(gm.w), bfhi(gm.w)};
                    if (first) { const u32x4 ga = gav[m][bj];
                        const float a[8] = {bflo(ga.x), bfhi(ga.x), bflo(ga.y), bfhi(ga.y), bflo(ga.z), bfhi(ga.z), bflo(ga.w), bfhi(ga.w)};
#pragma unroll
                        for (int j = 0; j < 4; ++j) { acc[ai][bj][m][0][j] *= a[j] / fmaxf(s[j], 1e-30f); acc[ai][bj][m][1][j] *= a[4 + j] / fmaxf(s[4 + j], 1e-30f); }
                    } else { const f32x4 v0 = acc[ai][bj][m][0], v1 = acc[ai][bj][m][1];
                        u32x4 w; w.x = cvt_pk_bf16(v0[0] * s[0], v0[1] * s[1]); w.y = cvt_pk_bf16(v0[2] * s[2], v0[3] * s[3]); w.z = cvt_pk_bf16(v1[0] * s[4], v1[1] * s[5]); w.w = cvt_pk_bf16(v1[2] * s[6], v1[3] * s[7]);
                        *(u32x4*)(Mrg + off) = w; } } }
            asm volatile("" ::: "memory"); }
        return first;
    }
};
struct EpiX1 {
    static constexpr bool PERM = false;
    const float* x; float* x1;
    __device__ __forceinline__ bool operator()(EPI_ARGS) const {
        const int row0 = u.pm * 256 + wr * 64 + fr, col0 = u.pn * 256 + wc * 32 + 4 * fq;
#pragma unroll
        for (int ai = 0; ai < 2; ++ai)
#pragma unroll
            for (int m = 0; m < 4; ++m) { const size_t off = (size_t)(row0 + ai * 128 + m * 16) * 2048 + col0;
#pragma unroll
                for (int bj = 0; bj < 2; ++bj)
#pragma unroll
                    for (int n = 0; n < 2; ++n) { const f32x4 xv = *(const f32x4*)(x + off + bj * 128 + n * 16); *(f32x4*)(x1 + off + bj * 128 + n * 16) = xv + acc[ai][bj][m][n]; } }
        return false;
    }
};
struct EpiGU {
    static constexpr bool PERM = true;
    const float* b_gu; unsigned char* Ha;
    __device__ __forceinline__ bool operator()(EPI_ARGS) const {
        const int e = u.z & 31; const int cw = wc * 32 + 8 * fq; const float* bg = b_gu + (size_t)e * 4096 + u.pn * 128 + cw;
        float bgv[8], buv[8];
#pragma unroll
        for (int j = 0; j < 8; ++j) { bgv[j] = bg[j]; buv[j] = bg[2048 + j]; }
#pragma unroll
        for (int ai = 0; ai < 2; ++ai)
#pragma unroll
            for (int m = 0; m < 4; ++m) { const size_t row = (size_t)e * CAP + (size_t)u.pm * 256 + wr * 64 + fr + ai * 128 + m * 16; float o[8];
#pragma unroll
                for (int j = 0; j < 8; ++j) { float gt = ((j < 4) ? acc[ai][0][m][0][j] : acc[ai][0][m][1][j - 4]) + bgv[j]; float up = ((j < 4) ? acc[ai][1][m][0][j] : acc[ai][1][m][1][j - 4]) + buv[j];
                    gt = fminf(gt, 7.0f); up = fminf(fmaxf(up, -7.0f), 7.0f);
                    o[j] = (up + 1.0f) * (gt * sigmoidf_(1.702f * gt)); }
                u32x2 w; w.x = pk4_fp8(o[0], o[1], o[2], o[3]); w.y = pk4_fp8(o[4], o[5], o[6], o[7]);
                *(u32x2*)(Ha + row * 2048 + u.pn * 128 + cw) = w; }
        return false;
    }
};
struct EpiDown {
    static constexpr bool PERM = true;
    const float* b_d; bf16* Ye;
    __device__ __forceinline__ bool operator()(EPI_ARGS) const {
        const int e = u.z & 31; const int cw = wc * 32 + 8 * fq;
        f32x4 bv[2][2];
#pragma unroll
        for (int bj = 0; bj < 2; ++bj)
#pragma unroll
            for (int n = 0; n < 2; ++n) bv[bj][n] = *(const f32x4*)(b_d + (size_t)e * 2048 + u.pn * 256 + bj * 128 + cw + 4 * n);
#pragma unroll
        for (int ai = 0; ai < 2; ++ai)
#pragma unroll
            for (int m = 0; m < 4; ++m) { const size_t row = (size_t)e * CAP + (size_t)u.pm * 256 + wr * 64 + fr + ai * 128 + m * 16;
#pragma unroll
                for (int bj = 0; bj < 2; ++bj) { const f32x4 v0 = acc[ai][bj][m][0] + bv[bj][0], v1 = acc[ai][bj][m][1] + bv[bj][1];
                    u32x4 w; w.x = cvt_pk_bf16(v0[0], v0[1]); w.y = cvt_pk_bf16(v0[2], v0[3]); w.z = cvt_pk_bf16(v1[0], v1[1]); w.w = cvt_pk_bf16(v1[2], v1[3]);
                    *(u32x4*)(Ye + row * 2048 + u.pn * 256 + bj * 128 + cw) = w; } }
        return false;
    }
};

struct EpiGUc {
    static constexpr bool PERM = true;
    const float* b_gu; unsigned char* Ha; unsigned* hcnt; mutable int pend;
    __device__ __forceinline__ void flush(int lane) const { if (pend >= 0 && lane == 0) __hip_atomic_fetch_add(hcnt + (size_t)pend * 16, 1u, __ATOMIC_RELAXED, __HIP_MEMORY_SCOPE_AGENT); pend = -1; }
    __device__ __forceinline__ bool operator()(EPI_ARGS) const {
        flush(fr + 16 * fq);
        const int e = u.z & 31; const int cw = wc * 32 + 8 * fq;
        const float* bg = b_gu + (size_t)e * 4096 + u.pn * 128 + cw; const f32x4 g0 = *(const f32x4*)bg, g1 = *(const f32x4*)(bg + 4), u0 = *(const f32x4*)(bg + 2048), u1 = *(const f32x4*)(bg + 2052);
        const float bgv[8] = {g0.x, g0.y, g0.z, g0.w, g1.x, g1.y, g1.z, g1.w}, buv[8] = {u0.x, u0.y, u0.z, u0.w, u1.x, u1.y, u1.z, u1.w};
#pragma unroll
        for (int ai = 0; ai < 2; ++ai)
#pragma unroll
            for (int m = 0; m < 4; ++m) { const size_t row = (size_t)e * CAP + (size_t)u.pm * 256 + wr * 64 + fr + ai * 128 + m * 16; float o[8];
#pragma unroll
                for (int j = 0; j < 8; ++j) { float gt = ((j < 4) ? acc[ai][0][m][0][j] : acc[ai][0][m][1][j - 4]) + bgv[j]; float up = ((j < 4) ? acc[ai][1][m][0][j] : acc[ai][1][m][1][j - 4]) + buv[j];
                    gt = fminf(gt, 7.0f); up = fminf(fmaxf(up, -7.0f), 7.0f);
                    o[j] = (up + 1.0f) * (gt * sigmoidf_(1.702f * gt)); }
                const unsigned long long w = (unsigned long long)pk4_fp8(o[0], o[1], o[2], o[3]) | ((unsigned long long)pk4_fp8(o[4], o[5], o[6], o[7]) << 32);
                __hip_atomic_store((unsigned long long*)(Ha + row * 2048 + u.pn * 128 + cw), w, __ATOMIC_RELAXED, __HIP_MEMORY_SCOPE_AGENT); }
        pend = e * 32 + u.pm;
        return false;
    }
};

struct Args { const float* in[22]; float* out; unsigned char* ws; int ph_lo, ph_hi, li, pad; };
struct Frame {
    LAS unsigned char* lds; int wave, G, bx;
    unsigned char* ws;
};
template <int OFF> __device__ __forceinline__ unsigned long long karg_u64() {
    auto kp = __builtin_amdgcn_kernarg_segment_ptr();
    unsigned long long v;
    asm volatile("s_load_dwordx2 %0, %1, %2\n\ts_waitcnt lgkmcnt(0)" : "=s"(v) : "s"(kp), "i"(OFF));
    return v;
}
#define INP(i) ((const float*)(const GAS float*)karg_u64<8 * (i)>())
#define OUTP() ((float*)(GAS float*)karg_u64<176>())
#define WSP() ((unsigned char*)(GAS unsigned char*)karg_u64<184>())

__device__ __forceinline__ void transpose_item(const float* src, size_t spitch, int k0, int n0, bf16* dst, size_t dpitch, int drow0, int dk0, LAS float* scr, int lane) {
#pragma unroll 8
    for (int i = 0; i < 32; ++i) { const int kk = 2 * i + (lane >> 5); scr[kk * 33 + (lane & 31)] = src[(size_t)(k0 + kk) * spitch + n0 + (lane & 31)]; }
    LDS_WAIT(); asm volatile("" ::: "memory");
    const int c = lane & 7;
#pragma unroll
    for (int j = 0; j < 4; ++j) { const int n = (lane >> 3) + 8 * j; const LAS float* s = scr + (8 * c) * 33 + n;
        u32x4 o; o.x = pk2(s[0 * 33], s[1 * 33]); o.y = pk2(s[2 * 33], s[3 * 33]); o.z = pk2(s[4 * 33], s[5 * 33]); o.w = pk2(s[6 * 33], s[7 * 33]);
        *(u32x4*)(dst + (size_t)(drow0 + n) * dpitch + dk0 + 8 * c) = o; }
    LDS_WAIT(); asm volatile("" ::: "memory");
}

__device__ __forceinline__ void transpose_item_fp8(const float* src, size_t spitch, int k0, int n0, unsigned char* dst, size_t dpitch, int drow0, int dk0, LAS float* scr, int lane) {
#pragma unroll 8
    for (int i = 0; i < 32; ++i) { const int kk = 2 * i + (lane >> 5); scr[kk * 33 + (lane & 31)] = src[(size_t)(k0 + kk) * spitch + n0 + (lane & 31)]; }
    LDS_WAIT(); asm volatile("" ::: "memory");
    const int c = lane & 3;
#pragma unroll
    for (int j = 0; j < 2; ++j) { const int n = (lane >> 2) + 16 * j; const LAS float* s = scr + (16 * c) * 33 + n;
        u32x4 o; o.x = pk4_fp8(s[0 * 33] * 64.f, s[1 * 33] * 64.f, s[2 * 33] * 64.f, s[3 * 33] * 64.f); o.y = pk4_fp8(s[4 * 33] * 64.f, s[5 * 33] * 64.f, s[6 * 33] * 64.f, s[7 * 33] * 64.f);
        o.z = pk4_fp8(s[8 * 33] * 64.f, s[9 * 33] * 64.f, s[10 * 33] * 64.f, s[11 * 33] * 64.f); o.w = pk4_fp8(s[12 * 33] * 64.f, s[13 * 33] * 64.f, s[14 * 33] * 64.f, s[15 * 33] * 64.f);
        *(u32x4*)(dst + (size_t)(drow0 + n) * dpitch + dk0 + 16 * c) = o; }
    LDS_WAIT(); asm volatile("" ::: "memory");
}

__device__ __forceinline__ void conv_item_bf16(const float* src, size_t spitch, int k0, int n0, bf16* dst, size_t dpitch, int drow0, int dk0, int lane) {
    const int kg = lane >> 3, ng = lane & 7; const float* s = src + (size_t)(k0 + kg * 16) * spitch + n0 + 4 * ng; f32x4 v[16];
#pragma unroll
    for (int i = 0; i < 16; ++i) v[i] = __builtin_nontemporal_load((const f32x4*)(s + (size_t)i * spitch));
    bf16* d = dst + (size_t)(drow0 + 4 * ng) * dpitch + dk0 + kg * 16;
#pragma unroll
    for (int c = 0; c < 4; ++c) { u32x4 o0, o1;
        o0.x = pk2(v[0][c], v[1][c]); o0.y = pk2(v[2][c], v[3][c]); o0.z = pk2(v[4][c], v[5][c]); o0.w = pk2(v[6][c], v[7][c]);
        o1.x = pk2(v[8][c], v[9][c]); o1.y = pk2(v[10][c], v[11][c]); o1.z = pk2(v[12][c], v[13][c]); o1.w = pk2(v[14][c], v[15][c]);
        *(u32x4*)(d + (size_t)c * dpitch) = o0; *(u32x4*)(d + (size_t)c * dpitch + 8) = o1; }
}

__device__ __forceinline__ void conv_item_fp8(const float* src, size_t spitch, int k0, int n0, unsigned char* dst, size_t dpitch, int drow0, int dk0, int lane) {
    const int kg = lane >> 3, ng = lane & 7; const float* s = src + (size_t)(k0 + kg * 16) * spitch + n0 + 4 * ng; f32x4 v[16];
#pragma unroll
    for (int i = 0; i < 16; ++i) v[i] = __builtin_nontemporal_load((const f32x4*)(s + (size_t)i * spitch));
    unsigned char* d = dst + (size_t)(drow0 + 4 * ng) * dpitch + dk0 + kg * 16;
#pragma unroll
    for (int c = 0; c < 4; ++c) { u32x4 o;
        o.x = pk4_fp8(v[0][c] * 64.f, v[1][c] * 64.f, v[2][c] * 64.f, v[3][c] * 64.f); o.y = pk4_fp8(v[4][c] * 64.f, v[5][c] * 64.f, v[6][c] * 64.f, v[7][c] * 64.f);
        o.z = pk4_fp8(v[8][c] * 64.f, v[9][c] * 64.f, v[10][c] * 64.f, v[11][c] * 64.f); o.w = pk4_fp8(v[12][c] * 64.f, v[13][c] * 64.f, v[14][c] * 64.f, v[15][c] * 64.f);
        *(u32x4*)(d + (size_t)c * dpitch) = o; }
}

__device__ __forceinline__ void conv_load(const float* src, size_t spitch, int k0, int n0, int lane, f32x4 (&v)[16]) {
    const int kg = lane >> 3, ng = lane & 7; const float* s = src + (size_t)(k0 + kg * 16) * spitch + n0 + 4 * ng;
#pragma unroll
    for (int i = 0; i < 16; ++i) v[i] = __builtin_nontemporal_load((const f32x4*)(s + (size_t)i * spitch));
}
__device__ __forceinline__ void conv_store_bf16(const f32x4 (&v)[16], bf16* dst, size_t dpitch, int drow0, int dk0, int lane) {
    const int kg = lane >> 3, ng = lane & 7; bf16* d = dst + (size_t)(drow0 + 4 * ng) * dpitch + dk0 + kg * 16;
#pragma unroll
    for (int c = 0; c < 4; ++c) { u32x4 o0, o1;
        o0.x = pk2(v[0][c], v[1][c]); o0.y = pk2(v[2][c], v[3][c]); o0.z = pk2(v[4][c], v[5][c]); o0.w = pk2(v[6][c], v[7][c]);
        o1.x = pk2(v[8][c], v[9][c]); o1.y = pk2(v[10][c], v[11][c]); o1.z = pk2(v[12][c], v[13][c]); o1.w = pk2(v[14][c], v[15][c]);
        *(u32x4*)(d + (size_t)c * dpitch) = o0; *(u32x4*)(d + (size_t)c * dpitch + 8) = o1; }
}
__device__ __forceinline__ void conv_store_fp8(const f32x4 (&v)[16], unsigned char* dst, size_t dpitch, int drow0, int dk0, int lane) {
    const int kg = lane >> 3, ng = lane & 7; unsigned char* d = dst + (size_t)(drow0 + 4 * ng) * dpitch + dk0 + kg * 16;
#pragma unroll
    for (int c = 0; c < 4; ++c) { u32x4 o;
        o.x = pk4_fp8(v[0][c] * 64.f, v[1][c] * 64.f, v[2][c] * 64.f, v[3][c] * 64.f); o.y = pk4_fp8(v[4][c] * 64.f, v[5][c] * 64.f, v[6][c] * 64.f, v[7][c] * 64.f);
        o.z = pk4_fp8(v[8][c] * 64.f, v[9][c] * 64.f, v[10][c] * 64.f, v[11][c] * 64.f); o.w = pk4_fp8(v[12][c] * 64.f, v[13][c] * 64.f, v[14][c] * 64.f, v[15][c] * 64.f);
        *(u32x4*)(d + (size_t)c * dpitch) = o; }
}

struct ConvPoolB {
    const float *pa, *pm, *wo; bf16 *pam, *wout; int first, n;
    __device__ __forceinline__ void run(int, int lane) const {
        for (int jj = 0; jj < n; ++jj) { int r = first + jj;
            if (r < 1024) { const int kb = r >> 6, nb = r & 63; conv_item_bf16(pa, 2048, kb * 128, nb * 32, pam, 4096, nb * 32, kb * 128, lane); continue; } r -= 1024;
            if (r < 1024) { const int kb = r >> 6, nb = r & 63; conv_item_bf16(pm, 2048, kb * 128, nb * 32, pam, 4096, nb * 32, 2048 + kb * 128, lane); continue; } r -= 1024;
            { const int kb = r >> 6, nb = r & 63; conv_item_bf16(wo, 2048, kb * 128, nb * 32, wout, 2048, nb * 32, kb * 128, lane); } }
    }
};

__device__ __forceinline__ void p0_prologue(Frame& F) {
    const int lane = lane_id(), tid = F.wave * 64 + lane; (void)tid;
    LAS float* scr = (LAS float*)(F.lds + F.wave * 16384);
    const int gw = F.bx * NWAVES + F.wave, NGW = F.G * NWAVES;
    const float* Win = INP(2);
    constexpr int I_IN = 16 * 512, I_P = 16 * 64;
    const int NITEMS = I_IN + (F.G == 256 ? 0 : 3 * I_P);
    for (int it = gw; it < I_IN; it += 2 * NGW) { f32x4 va[16], vb[16]; const int it2 = it + NGW; const bool two = it2 < I_IN;
        { const int kb = it >> 9, n0 = (it & 511) * 32; conv_load(Win, INC, kb * 128, n0 < 12288 ? n0 : n0 + 8, lane, va); }
        if (two) { const int kb = it2 >> 9, n0 = (it2 & 511) * 32; conv_load(Win, INC, kb * 128, n0 < 12288 ? n0 : n0 + 8, lane, vb); }
        { const int kb = it >> 9, n0 = (it & 511) * 32;
          if (n0 < N_BF16_TILES * 256) conv_store_bf16(va, (bf16*)(F.ws + WS_WIN), 2048, n0, kb * 128, lane); else conv_store_fp8(va, (unsigned char*)(F.ws + WS_WIN8), 2048, n0 - N_BF16_TILES * 256, kb * 128, lane); }
        if (two) { const int kb = it2 >> 9, n0 = (it2 & 511) * 32;
          if (n0 < N_BF16_TILES * 256) conv_store_bf16(vb, (bf16*)(F.ws + WS_WIN), 2048, n0, kb * 128, lane); else conv_store_fp8(vb, (unsigned char*)(F.ws + WS_WIN8), 2048, n0 - N_BF16_TILES * 256, kb * 128, lane); }
    }
    for (int it = I_IN + gw; it < NITEMS; it += NGW) {
        int r = it - I_IN;
        if (r < I_P) { const int kb = r >> 6, nb = r & 63; conv_item_bf16(INP(11), 2048, kb * 128, nb * 32, (bf16*)(F.ws + WS_PAM), 4096, nb * 32, kb * 128, lane); continue; } r -= I_P;
        if (r < I_P) { const int kb = r >> 6, nb = r & 63; conv_item_bf16(INP(12), 2048, kb * 128, nb * 32, (bf16*)(F.ws + WS_PAM), 4096, nb * 32, 2048 + kb * 128, lane); continue; } r -= I_P;
        { const int kb = r >> 6, nb = r & 63; conv_item_bf16(INP(13), 2048, kb * 128, nb * 32, (bf16*)(F.ws + WS_WOUT), 2048, nb * 32, kb * 128, lane); }
    }
    { bf16* Wbd = (bf16*)(F.ws + WS_WBD); const float* wsgu = INP(6);
      for (int i = F.bx * NTHR + tid; i < 8 * 256 * 256; i += F.G * NTHR) { const int g = i >> 16, t = (i >> 8) & 255, s = i & 255; float v = 0.f;
          if ((t >> 7) == (s >> 7)) { const int tt = t & 127, ss = s & 127; if ((ss >> 6) <= (tt >> 6)) v = wsgu[(g * 128 + tt) * 128 + ss]; }
          Wbd[i] = (bf16)f2bf(v); } }
    __syncthreads();
    LAS float* wg = (LAS float*)F.lds;
    for (int i = tid; i < 2048 * 8; i += NTHR) { const int ch = i >> 3, q = i & 7; wg[(((((ch >> 8) * 4 + (ch & 3)) * 2 + (q >> 2)) * 64 + ((ch >> 2) & 63)) << 2) + (q & 3)] = Win[(size_t)ch * INC + 12288 + q]; }
    __syncthreads();
    const float* x = INP(0); const float* gmix = INP(1); const float* b_in = INP(3);
    bf16* H = (bf16*)(F.ws + WS_H); float* G8 = (float*)(F.ws + WS_G8);
    f32x4 gv[8], xn[8];
#pragma unroll
    for (int j = 0; j < 8; ++j) gv[j] = ((const f32x4*)gmix)[64 * j + lane];
    if (gw < T) {
#pragma unroll
        for (int j = 0; j < 8; ++j) xn[j] = ((const f32x4*)(x + (size_t)gw * D) + lane)[64 * j]; }
    for (int mrow = gw; mrow < T; mrow += NGW) {
        f32x4 xv[8]; float s = 0.f;
#pragma unroll
        for (int j = 0; j < 8; ++j) { xv[j] = xn[j]; s += (xv[j].x * xv[j].x + xv[j].y * xv[j].y) + (xv[j].z * xv[j].z + xv[j].w * xv[j].w); }
        if (mrow + NGW < T) {
#pragma unroll
            for (int j = 0; j < 8; ++j) xn[j] = ((const f32x4*)(x + (size_t)(mrow + NGW) * D) + lane)[64 * j]; }
        const float rstd = 1.0f / sqrtf(wave_sum(s) * (1.0f / D) + EPS);
        float ga[8];
#pragma unroll
        for (int q = 0; q < 8; ++q) ga[q] = 0.f;
        unsigned long long* o8 = (unsigned long long*)(H + (size_t)mrow * D) + lane;
#pragma unroll
        for (int j = 0; j < 8; ++j) { const f32x4 hv = xv[j] * rstd * gv[j];
            o8[64 * j] = (unsigned long long)pk2(hv.x, hv.y) | ((unsigned long long)pk2(hv.z, hv.w) << 32);
            ((unsigned*)((unsigned char*)(F.ws + WS_H8) + (size_t)mrow * D))[64 * j + lane] = pk4_fp8(hv.x, hv.y, hv.z, hv.w);
            const LAS float* wp = wg + j * 2048 + lane * 4;
#pragma unroll
            for (int i = 0; i < 4; ++i) { const f32x4 w0 = *(const LAS f32x4*)(wp + i * 512), w1 = *(const LAS f32x4*)(wp + i * 512 + 256);
                ga[0] += hv[i] * w0.x; ga[1] += hv[i] * w0.y; ga[2] += hv[i] * w0.z; ga[3] += hv[i] * w0.w; ga[4] += hv[i] * w1.x; ga[5] += hv[i] * w1.y; ga[6] += hv[i] * w1.z; ga[7] += hv[i] * w1.w; }
            asm volatile("" ::: "memory"); }
#pragma unroll
        for (int q = 0; q < 8; ++q) ga[q] = wave_sum(ga[q]);
        if (lane < 8) { float val = ga[0];
#pragma unroll
            for (int q = 1; q < 8; ++q) val = (lane == q) ? ga[q] : val;
            G8[(size_t)mrow * 8 + lane] = val + b_in[12288 + lane]; }
    }
    __syncthreads();
}

__device__ __forceinline__ void p2_elementwise(Frame& F) {
    const int lane = lane_id(), tid = F.wave * 64 + lane; (void)tid;
    if (F.bx < 16 && F.wave == 0) {
        const int bh = F.bx, b = bh >> 2, h = bh & 3; const float* gp = (const float*)(F.ws + WS_G8) + ((size_t)b * 2048 + lane * 32) * 8;
        float* aS = (float*)(F.ws + WS_AS) + bh * 2048 + lane * 32; float* Mt = (float*)(F.ws + WS_MT) + bh * 2048 + lane * 32; float* Bm = (float*)(F.ws + WS_BM) + bh * 2048 + lane * 32;
        float lf[32], av[32];
#pragma unroll
        for (int c = 0; c < 32; ++c) { const float fg = gp[c * 8 + 4 + h]; av[c] = gp[c * 8 + h]; lf[c] = fminf(fg, 0.f) - log1pf(expf(-fabsf(fg))); }
        double tot = 0.0;
#pragma unroll
        for (int c = 0; c < 32; ++c) tot += (double)lf[c];
#pragma unroll
        for (int o = 1; o < 64; o <<= 1) { const double t = __shfl_up(tot, o); if (lane >= o) tot += t; }
        double excl = __shfl_up(tot, 1); if (lane == 0) excl = 0.0;
        double run = excl; float lm = -3.0e38f;
#pragma unroll
        for (int c = 0; c < 32; ++c) { run += (double)lf[c]; av[c] -= (float)run; lm = fmaxf(lm, av[c]); }
#pragma unroll
        for (int o = 1; o < 64; o <<= 1) { const float t = __shfl_up(lm, o); if (lane >= o) lm = fmaxf(lm, t); }
        float mx = __shfl_up(lm, 1); if (lane == 0) mx = 0.f; mx = fmaxf(mx, 0.f);
        run = excl;
#pragma unroll
        for (int c4 = 0; c4 < 8; ++c4) { f32x4 a4, m4, b4;
#pragma unroll
            for (int j = 0; j < 4; ++j) { const int c = c4 * 4 + j; run += (double)lf[c]; mx = fmaxf(mx, av[c]); a4[j] = av[c]; m4[j] = mx; b4[j] = (float)(run + (double)mx); }
            *(f32x4*)(aS + c4 * 4) = a4; *(f32x4*)(Mt + c4 * 4) = m4; *(f32x4*)(Bm + c4 * 4) = b4; }
    }
    const int gt = F.bx * NTHR + tid, NT_ = F.G * NTHR;
    { const bf16* QKr = (const bf16*)(F.ws + WS_QKR); bf16* QKc = (bf16*)(F.ws + WS_QKC); const float* wc = INP(4); const float* bc = INP(5);
      const int c0 = (gt & 511) * 8; const float sc = (c0 < 2048) ? 0.04419417382f : 1.0f;
      f32x4 w[4][2];
#pragma unroll
      for (int k = 0; k < 4; ++k) { w[k][0] = *(const f32x4*)(wc + k * 4096 + c0); w[k][1] = *(const f32x4*)(wc + k * 4096 + c0 + 4); }
      const f32x4 b0 = *(const f32x4*)(bc + c0), b1 = *(const f32x4*)(bc + c0 + 4);
      for (int it = gt; it < (T / 4) * 512; it += 2 * NT_) { u32x4 z[2][7]; int tk[2];
#pragma unroll
          for (int q = 0; q < 2; ++q) { const int itq = it + q * NT_; const bool ok = itq < (T / 4) * 512; const int tok = ok ? (itq >> 9) * 4 : 0; tk[q] = ok ? tok : -1; const int s = tok & 2047;
#pragma unroll
              for (int r = 0; r < 7; ++r) { z[q][r] = (u32x4){0u, 0u, 0u, 0u}; if (r >= 3 || s > 0) z[q][r] = *(const u32x4*)(QKr + (size_t)(tok - 3 + r) * 4096 + c0); } }
#pragma unroll
          for (int q = 0; q < 2; ++q) { if (tk[q] < 0) continue;
#pragma unroll
              for (int o = 0; o < 4; ++o) { f32x4 a0 = b0, a1 = b1;
#pragma unroll
                  for (int k = 0; k < 4; ++k) { const u32x4 zz = z[q][o + k];
                      a0.x += bflo(zz.x) * w[k][0].x; a0.y += bfhi(zz.x) * w[k][0].y; a0.z += bflo(zz.y) * w[k][0].z; a0.w += bfhi(zz.y) * w[k][0].w;
                      a1.x += bflo(zz.z) * w[k][1].x; a1.y += bfhi(zz.z) * w[k][1].y; a1.z += bflo(zz.w) * w[k][1].z; a1.w += bfhi(zz.w) * w[k][1].w; }
#pragma unroll
                  for (int j = 0; j < 4; ++j) { a0[j] = a0[j] * sigmoidf_(a0[j]) * sc; a1[j] = a1[j] * sigmoidf_(a1[j]) * sc; }
                  u32x4 ov; ov.x = pk2(a0.x, a0.y); ov.y = pk2(a0.z, a0.w); ov.z = pk2(a1.x, a1.y); ov.w = pk2(a1.z, a1.w);
                  *(u32x4*)(QKc + (size_t)(tk[q] + o) * 4096 + c0) = ov; } } } }
    { bf16* VgT = (bf16*)(F.ws + WS_VGT); const float* vpart = (const float*)(F.ws + WS_VPART); const float* gln = INP(8); const float* bln = INP(9);
      LAS float* st = (LAS float*)(F.lds + MISC_OFF + 64);
      for (int bi = F.bx; bi < T / 32; bi += F.G) {
          const int xq = bi & 7, qq = (bi >> 3) & 31, hi_ = bi >> 8; const int blk = hi_ * 256 + 2 * (8 * (qq >> 1) + xq) + (qq & 1);
          const int tok0 = blk * 32, b = tok0 >> 11, s0 = tok0 & 2047;
          __syncthreads();
          if (tid < 32) { const f32x4* vp = (const f32x4*)(vpart + (size_t)(tok0 + tid) * 64); float sm = 0.f, sq = 0.f;
#pragma unroll
              for (int q = 0; q < 8; ++q) { const f32x4 a = vp[q], c = vp[8 + q]; sm += (a.x + a.y) + (a.z + a.w); sq += (c.x + c.y) + (c.z + c.w); }
              const float mu = sm * (1.0f / 2048.0f); const float var = fmaxf(sq * (1.0f / 2048.0f) - mu * mu, 0.f); st[tid] = mu; st[32 + tid] = 1.0f / sqrtf(var + EPS); }
          __syncthreads();
          u32x4 zv[16];
#pragma unroll
          for (int k = 0; k < 16; ++k) { const int i = tid + k * NTHR; const int d = i >> 2, grp = i & 3; zv[k] = *(const u32x4*)(VgT + ((size_t)(b * 2048 + d) * 2048 + s0 + grp * 8)); }
#pragma unroll
          for (int k = 0; k < 16; ++k) { const int i = tid + k * NTHR; const int d = i >> 2, grp = i & 3; bf16* p = VgT + ((size_t)(b * 2048 + d) * 2048 + s0 + grp * 8);
              const u32x4 z = zv[k]; const float gg = gln[d], bb = bln[d];
              float v[8] = {bflo(z.x), bfhi(z.x), bflo(z.y), bfhi(z.y), bflo(z.z), bfhi(z.z), bflo(z.w), bfhi(z.w)};
#pragma unroll
              for (int j = 0; j < 8; ++j) v[j] = (v[j] - st[grp * 8 + j]) * st[32 + grp * 8 + j] * gg + bb;
              u32x4 o; o.x = pk2(v[0], v[1]); o.y = pk2(v[2], v[3]); o.z = pk2(v[4], v[5]); o.w = pk2(v[6], v[7]);
              *(u32x4*)p = o; } }
      __syncthreads(); }
}

__device__ __forceinline__ void p5_ym(Frame& F) {
    const int lane = lane_id(), tid = F.wave * 64 + lane; (void)tid;
    const int gt = F.bx * NTHR + tid, NT_ = F.G * NTHR;
    const bf16* Hm = (const bf16*)(F.ws + WS_HM); const bf16* Og = (const bf16*)(F.ws + WS_OG); const float* ssqp = (const float*)(F.ws + WS_SSQP); const float* gn = INP(10);
    bf16* Y = (bf16*)(F.ws + WS_Y);
    for (int it = gt; it < T * 256; it += NT_) { const int tok = it >> 8, c0 = (it & 255) * 8, h = c0 >> 9;
        const f32x4 q0 = *(const f32x4*)(ssqp + (size_t)(tok * 4 + h) * 8), q1 = *(const f32x4*)(ssqp + (size_t)(tok * 4 + h) * 8 + 4);
        const float rstd = 1.0f / sqrtf((((q0.x + q0.y) + (q0.z + q0.w)) + ((q1.x + q1.y) + (q1.z + q1.w))) * (1.0f / 512.0f) + EPS);
        const u32x4 hv = *(const u32x4*)(Hm + (size_t)tok * 2048 + c0), ov = *(const u32x4*)(Og + (size_t)tok * 2048 + c0);
        const f32x4 g0 = *(const f32x4*)(gn + c0), g1 = *(const f32x4*)(gn + c0 + 4);
        u32x4 o; o.x = pk2(bflo(hv.x) * rstd * g0.x * bflo(ov.x), bfhi(hv.x) * rstd * g0.y * bfhi(ov.x)); o.y = pk2(bflo(hv.y) * rstd * g0.z * bflo(ov.y), bfhi(hv.y) * rstd * g0.w * bfhi(ov.y));
        o.z = pk2(bflo(hv.z) * rstd * g1.x * bflo(ov.z), bfhi(hv.z) * rstd * g1.y * bfhi(ov.z)); o.w = pk2(bflo(hv.w) * rstd * g1.z * bflo(ov.w), bfhi(hv.w) * rstd * g1.w * bfhi(ov.w));
        *(u32x4*)(Y + (size_t)tok * 4096 + 2048 + c0) = o; }
}

__device__ __forceinline__ void p8_router(Frame& F) {
    const int lane = lane_id(), tid = F.wave * 64 + lane; (void)tid;
    const float* x1 = (const float*)(F.ws + WS_X1); const float* gmoe = INP(14); const float* Wr = INP(15); const float* br = INP(16);
    LAS float* hT = (LAS float*)F.lds;
    LAS float* WrL = (LAS float*)(F.lds + 65536);
    LAS float* red = (LAS float*)(F.lds + 81920);
    LAS float* misc = (LAS float*)(F.lds + MISC_OFF + 64);
    LAS float* rstd_s = misc; LAS int* sel_e = (LAS int*)(misc + 32); LAS float* sel_g = misc + 32 + 128; LAS int* sel_pos = (LAS int*)(misc + 32 + 256);
    LAS int* lcnt = (LAS int*)(misc + 32 + 384); LAS int* lbase = lcnt + 32;
    if (tid < 32) lcnt[tid] = 0;
    int* ecnt = (int*)(F.ws + CTLB_ECNT); int* slot = (int*)(F.ws + WS_SLOT); float* slotg = (float*)(F.ws + WS_SLOT + 128 * 1024);
    unsigned char* Xs = (unsigned char*)(F.ws + WS_XS);
    for (int tb = F.bx; tb < T / 32; tb += F.G) {
        const int tok0 = tb * 32;
        float accr[16];
#pragma unroll
        for (int q = 0; q < 16; ++q) accr[q] = 0.f;
        float ssl[4] = {0.f, 0.f, 0.f, 0.f};
        float xv[8][4], gq[8]; f32x4 wv[8];
#define ROUTER_ISSUE(qq) do { _Pragma("unroll") for (int i = 0; i < 8; ++i) { const int c = 64 * i + lane; gq[i] = gmoe[(qq) * 512 + c]; \
            _Pragma("unroll") for (int r = 0; r < 4; ++r) xv[i][r] = x1[(size_t)(tok0 + F.wave * 4 + r) * D + (qq) * 512 + c]; \
            wv[i] = ((const f32x4*)(Wr + (size_t)(qq) * 512 * 32))[i * NTHR + tid]; } } while (0)
        ROUTER_ISSUE(0);
#pragma unroll 1
        for (int qt = 0; qt < 4; ++qt) {
            __syncthreads();
#pragma unroll
            for (int i = 0; i < 8; ++i) { const int c = 64 * i + lane; f32x4 hv;
#pragma unroll
                for (int r = 0; r < 4; ++r) { const float v = xv[i][r]; ssl[r] += v * v; hv[r] = v * gq[i]; }
                *(LAS f32x4*)(hT + c * 32 + ((4 * F.wave) ^ ((c & 7) << 2))) = hv;
                *(LAS f32x4*)(WrL + (size_t)(i * NTHR + tid) * 4) = wv[i]; }
            if (qt < 3) ROUTER_ISSUE(qt + 1);
            __syncthreads();
            const int tg = lane & 7, eg = lane >> 3;
#pragma unroll 8
            for (int cc = 0; cc < 64; ++cc) { const int c = F.wave * 64 + cc; const f32x4 h4 = *(const LAS f32x4*)(hT + c * 32 + ((4 * tg) ^ ((c & 7) << 2))); const f32x4 w4 = *(const LAS f32x4*)(WrL + c * 32 + 4 * eg);
#pragma unroll
                for (int a = 0; a < 4; ++a) { accr[a * 4 + 0] += h4[a] * w4.x; accr[a * 4 + 1] += h4[a] * w4.y; accr[a * 4 + 2] += h4[a] * w4.z; accr[a * 4 + 3] += h4[a] * w4.w; } }
        }
#undef ROUTER_ISSUE
        __syncthreads();
#pragma unroll
        for (int r = 0; r < 4; ++r) { const float s = wave_sum(ssl[r]); if (lane == 0) rstd_s[F.wave * 4 + r] = 1.0f / sqrtf(s * (1.0f / D) + EPS); }
#pragma unroll
        for (int q = 0; q < 16; ++q) red[(F.wave * 64 + lane) * 17 + q] = accr[q];
        __syncthreads();
        LAS float* lg = (LAS float*)(F.lds + 81920 + 36864);
        for (int o = tid; o < 1024; o += NTHR) { const int tl = o >> 5, e = o & 31; const int ln = (e >> 2) * 8 + (tl >> 2), q = (tl & 3) * 4 + (e & 3); float s = 0.f;
#pragma unroll
            for (int w = 0; w < 8; ++w) s += red[(w * 64 + ln) * 17 + q];
            lg[tl * 33 + e] = s * rstd_s[tl] + br[e]; }
        __syncthreads();
        int id[4]; float gk[4]; int lr[4];
        if (tid < 32) { const int tl = tid; float v[4]; unsigned used = 0u;
#pragma unroll
            for (int k = 0; k < 4; ++k) { float best = -3.0e38f; int bi = 0;
                for (int e = 0; e < 32; ++e) { const float x = lg[tl * 33 + e]; if (!((used >> e) & 1u) && x > best) { best = x; bi = e; } }
                used |= 1u << bi; v[k] = best; id[k] = bi; }
            const float e1 = fast_exp(v[1] - v[0]), e2 = fast_exp(v[2] - v[0]), e3 = fast_exp(v[3] - v[0]); const float inv = 1.0f / (1.0f + e1 + e2 + e3);
            gk[0] = inv; gk[1] = e1 * inv; gk[2] = e2 * inv; gk[3] = e3 * inv;
#pragma unroll
            for (int k = 0; k < 4; ++k) lr[k] = atomicAdd((int*)(lcnt + id[k]), 1);
        }
        __syncthreads();
        if (tid < 32) { const int n = lcnt[tid]; lbase[tid] = n ? atomicAdd(ecnt + tid * 64, n) : 0; }
        __syncthreads();
        if (tid < 32) { const int tl = tid;
#pragma unroll
            for (int k = 0; k < 4; ++k) { const int pos = lbase[id[k]] + lr[k]; sel_e[tl * 4 + k] = id[k]; sel_g[tl * 4 + k] = gk[k]; sel_pos[tl * 4 + k] = pos;
                slot[(size_t)(tok0 + tl) * 4 + k] = (id[k] << 16) | pos; slotg[(size_t)(tok0 + tl) * 4 + k] = gk[k]; }
            lcnt[tl] = 0; }
        __syncthreads();
#pragma unroll
        for (int r = 0; r < 4; ++r) { const int tl = F.wave * 4 + r; const float rs = rstd_s[tl]; const f32x4* xr = (const f32x4*)(x1 + (size_t)(tok0 + tl) * D) + lane;
            unsigned pk[8];
#pragma unroll
            for (int j = 0; j < 8; ++j) { const f32x4 v = xr[64 * j]; const f32x4 gg = ((const f32x4*)gmoe)[64 * j + lane];
                pk[j] = pk4_fp8(v.x * rs * gg.x, v.y * rs * gg.y, v.z * rs * gg.z, v.w * rs * gg.w); }
#pragma unroll
            for (int k = 0; k < 4; ++k) { const int e = sel_e[tl * 4 + k], pos = sel_pos[tl * 4 + k]; unsigned* o4 = (unsigned*)(Xs + ((size_t)e * CAP + pos) * D) + lane;
#pragma unroll
                for (int j = 0; j < 8; ++j) o4[64 * j] = pk[j]; } }
    }
    __syncthreads();
}

__device__ __forceinline__ void moe_table(Frame& F, volatile LAS int* tab, int NT) {
    const int lane = lane_id(), tid = F.wave * 64 + lane;
    __syncthreads();
    if (tid < 64) { const int* ecnt = (const int*)(F.ws + CTLB_ECNT); const int e = lane & 31;
        const int cnt = __hip_atomic_load(ecnt + e * 64, __ATOMIC_RELAXED, __HIP_MEMORY_SCOPE_AGENT); const int t = (cnt + 255) >> 8;
        if ((F.G & 7) == 0) { const int x = F.bx & 7; int rank = 0;
            for (int k = 0; k < 32; ++k) { const int tk = __shfl(t, k); rank += (tk > t || (tk == t && k < e)) ? 1 : 0; }
            const int rnd = rank >> 3, pos = rank & 7, g = (rnd & 1) ? 7 - pos : pos;
            if (lane < 32 && g == x) { tab[40 + rnd] = t; tab[48 + rnd] = e; }
            LDS_WAIT(); asm volatile("" ::: "memory");
            if (lane == 0) { int pre = 0; tab[0] = 0; for (int j = 0; j < 4; ++j) { pre += tab[40 + j] * NT; tab[j + 1] = pre; } }
        } else { int pre = t * NT;
#pragma unroll
            for (int o = 1; o < 32; o <<= 1) { const int v = __shfl_up(pre, o); if ((lane & 31) >= o) pre += v; }
            if (lane < 32) { tab[e + 1] = pre; tab[40 + e] = t; tab[80 + e] = e; if (e == 0) tab[0] = 0; } }
    }
    __syncthreads();
}

__device__ __forceinline__ void p11_combine(Frame& F) {
    const int lane = lane_id(), tid = F.wave * 64 + lane; (void)tid;
    const int gw = F.bx * NWAVES + F.wave, NGW = F.G * NWAVES;
    const float* x1 = (const float*)(F.ws + WS_X1); const bf16* Ye = (const bf16*)(F.ws + WS_YE); const int* slot = (const int*)(F.ws + WS_SLOT); const float* slotg = (const float*)(F.ws + WS_SLOT + 128 * 1024);
    const float* gf = INP(21); float* outp = OUTP();
    for (int tok0 = gw; tok0 < T; tok0 += 2 * NGW) {
        const int tokb = (tok0 + NGW < T) ? tok0 + NGW : tok0; int sl[2][4]; float gk[2][4];
#pragma unroll
        for (int q = 0; q < 2; ++q) { const int tok = q ? tokb : tok0; const int4 s4 = *(const int4*)(slot + (size_t)tok * 4); const f32x4 g4 = *(const f32x4*)(slotg + (size_t)tok * 4);
            sl[q][0] = s4.x; sl[q][1] = s4.y; sl[q][2] = s4.z; sl[q][3] = s4.w; gk[q][0] = g4.x; gk[q][1] = g4.y; gk[q][2] = g4.z; gk[q][3] = g4.w; }
        f32x4 v[2][8]; unsigned long long y[2][4][8];
#pragma unroll
        for (int q = 0; q < 2; ++q) { const int tok = q ? tokb : tok0; const f32x4* xr = (const f32x4*)(x1 + (size_t)tok * D) + lane;
#pragma unroll
            for (int j = 0; j < 8; ++j) v[q][j] = xr[64 * j]; }
#pragma unroll
        for (int q = 0; q < 2; ++q)
#pragma unroll
            for (int k = 0; k < 4; ++k) { const int e = sl[q][k] >> 16, pos = sl[q][k] & 0xffff; const unsigned long long* yr = (const unsigned long long*)(Ye + ((size_t)e * CAP + pos) * D) + lane;
#pragma unroll
                for (int j = 0; j < 8; ++j) y[q][k][j] = yr[64 * j]; }
#pragma unroll
        for (int q = 0; q < 2; ++q) { const int tok = q ? tokb : tok0;
#pragma unroll
            for (int k = 0; k < 4; ++k)
#pragma unroll
                for (int j = 0; j < 8; ++j) { const unsigned lo = (unsigned)y[q][k][j], hi = (unsigned)(y[q][k][j] >> 32); const float g = gk[q][k];
                    v[q][j].x += g * bflo(lo); v[q][j].y += g * bfhi(lo); v[q][j].z += g * bflo(hi); v[q][j].w += g * bfhi(hi); }
            float s = 0.f;
#pragma unroll
            for (int j = 0; j < 8; ++j) s += (v[q][j].x * v[q][j].x + v[q][j].y * v[q][j].y) + (v[q][j].z * v[q][j].z + v[q][j].w * v[q][j].w);
            const float rstd = 1.0f / sqrtf(wave_sum(s) * (1.0f / D) + EPS);
            f32x4* orow = (f32x4*)(outp + (size_t)tok * D) + lane;
            if (q == 0 || tokb != tok0) {
#pragma unroll
                for (int j = 0; j < 8; ++j) { const f32x4 gg = ((const f32x4*)gf)[64 * j + lane]; orow[64 * j] = v[q][j] * rstd * gg; } } }
    }
}

constexpr int N_PHASES = 13;
__global__ void __launch_bounds__(NTHR, 2) mk_fwd(Args args) {
    extern __shared__ __attribute__((aligned(16))) unsigned char lds_raw[];
    Frame F; F.lds = (LAS unsigned char*)lds_raw; F.wave = __builtin_amdgcn_readfirstlane((int)threadIdx.x >> 6); F.G = gridDim.x; F.bx = blockIdx.x;
    const int tid = F.wave * 64 + lane_id();
    F.ws = WSP();
    volatile LAS unsigned* MISC = (volatile LAS unsigned*)(F.lds + MISC_OFF);
    for (int i = tid; i < 256; i += NTHR) MISC[i] = 0u;
    __syncthreads();
    if (MK_N_LAUNCHES == 1) (void)xcd_barrier_post((unsigned*)(F.ws + WS_CTL) + 4096, MISC, tid == 0);
#define GRIDBAR() do { XcdBarrier _b; _b.bar = (unsigned*)(WSP() + WS_CTL) + 4096; _b.x = xb_xcc_id(); _b.st = (volatile LAS unsigned*)(F.lds + MISC_OFF); _b.G = (unsigned)F.G; xcd_barrier(_b, F.wave); } while (0)
    const int lo = args.ph_lo, hi = args.ph_hi;
#ifdef PH_ONLY
#define IN(k) ((k) == PH_ONLY && lo <= (k) && (k) < hi)
#else
#define IN(k) (lo <= (k) && (k) < hi)
#endif
#define SEAM(k) do { if (IN(k) && IN((k) + 1)) GRIDBAR(); } while (0)
#ifdef PROBE_DUP
#define REP(k) for (int _r = 0; _r < ((k) == PROBE_DUP ? 2 : 1); ++_r, ((k) == PROBE_DUP && _r == 1) ? ({ GRIDBAR(); }) : (void)0)
#else
#define REP(k)
#endif
    LAS unsigned char* ring = F.lds;
    if (lane_id() == 0) *((volatile LAS int*)(F.lds + MISC_OFF + 3072) + F.wave) = 0;
#define MKHOOK() const ConvHook HK{INP(17), INP(19), (unsigned char*)(F.ws + WS_WGU), (unsigned char*)(F.ws + WS_WD), (volatile LAS int*)(F.lds + MISC_OFF + 3072) + F.wave, F.bx * NWAVES + F.wave, F.G * NWAVES}
    volatile LAS int* tab = (volatile LAS int*)(F.lds + MISC_OFF + 4096);

    if (IN(0)) REP(0) { F.ws = WSP(); unsigned char* const ws = F.ws; (void)ws; p0_prologue(F); } SEAM(0);
    if (IN(1)) REP(1) { F.ws = WSP(); unsigned char* const ws = F.ws; (void)ws;
        EpiIn E{INP(3), ws};
        MKHOOK(); const int grp3 = (F.bx >> 3) % 3; if (grp3 == 0) HK.run(CONV_ITEMS_PER_WAVE, lane_id());
        { SchedGrid S{(const char*)(ws + WS_H), (const char*)(ws + WS_WIN), 4096u, 4096u, 32, N_BF16_TILES, F.G, F.bx, 32};
          pg8::gemm_phase<EpiIn, SchedGrid, ConvHook>(ring, F.wave, pg8::Gemm{4096u, 4096u}, S, E, HK, grp3 == 1 ? CONV_ITEMS_PER_WAVE : 0, 2); }
        { SchedGrid S{(const char*)(ws + WS_H8), (const char*)(ws + WS_WIN8), 2048u, 2048u, 32, N_FP8_TILES, F.G, F.bx, 16, N_BF16_TILES};
          pg8::gemm_phase<EpiIn, SchedGrid, ConvHook, true>(ring, F.wave, pg8::Gemm{2048u, 2048u}, S, E, HK, grp3 == 2 ? CONV_ITEMS_PER_WAVE : 0, -2); }
    } SEAM(1);
    if (IN(2)) REP(2) { F.ws = WSP(); unsigned char* const ws = F.ws; (void)ws; p2_elementwise(F); } SEAM(2);
    if (IN(3)) REP(3) { F.ws = WSP(); unsigned char* const ws = F.ws; (void)ws;
        SchedSgu S{(const char*)(ws + WS_WBD), (const char*)(ws + WS_VGT), F.G, F.bx};
        EpiSgu E{(const bf16*)(ws + WS_UG), INP(7), (bf16*)(ws + WS_Y)};
        MKHOOK(); pg8::gemm_phase<EpiSgu, SchedSgu, ConvHook>(ring, F.wave, pg8::Gemm{512u, 4096u}, S, E, HK, 0);
    }
    if (IN(4)) REP(4) { F.ws = WSP(); unsigned char* const ws = F.ws; (void)ws;
        SchedQK S{(const char*)(ws + WS_QKC), F.G, F.bx};
        EpiQK E{(const float*)(ws + WS_AS), (const float*)(ws + WS_MT), (bf16*)(ws + WS_P), (float*)(ws + WS_DENP)};
        const ConvPoolB HP{INP(11), INP(12), INP(13), (bf16*)(ws + WS_PAM), (bf16*)(ws + WS_WOUT), ((F.bx - 64) * NWAVES + F.wave) * 2, (F.G == 256 && F.bx >= 64) ? 2 : 0};
        pg8::gemm_phase<EpiQK, SchedQK, ConvPoolB>(ring, F.wave, pg8::Gemm{8192u, 8192u}, S, E, HP, 1, -2);
    } SEAM(4);
    if (IN(5)) REP(5) { F.ws = WSP(); unsigned char* const ws = F.ws; (void)ws;
        SchedPV S{(const char*)(ws + WS_P), (const char*)(ws + WS_VMT), F.G, F.bx};
        EpiPV E{(const float*)(ws + WS_DENP), (const float*)(ws + WS_BM), (bf16*)(ws + WS_HM), (float*)(ws + WS_SSQP)};
        MKHOOK(); const int g5 = (F.bx >> 5) & 7, n5 = (int)((CONV_P5_N >> (4 * g5)) & 15u), pre5 = (int)((CONV_P5_PRE >> (8 * g5)) & 255ull);
        const ConvPool HP{HK, CONV_POOL5 + 256 * pre5 + ((F.bx & 31) * NWAVES + F.wave) * n5, (F.G == 256) ? n5 : 0};
        pg8::gemm_phase<EpiPV, SchedPV, ConvPool>(ring, F.wave, pg8::Gemm{4096u, 4096u}, S, E, HP, 1, -2);
    } SEAM(5);
    if (IN(6)) REP(6) { F.ws = WSP(); unsigned char* const ws = F.ws; (void)ws; p5_ym(F); } SEAM(6);
    if (IN(7)) REP(7) { F.ws = WSP(); unsigned char* const ws = F.ws; (void)ws;
        SchedMerge S{(const char*)(ws + WS_Y), (const char*)(ws + WS_PAM), F.G, F.bx};
        EpiMerge E{(const bf16*)(ws + WS_GA), (const bf16*)(ws + WS_GM), (bf16*)(ws + WS_MRG)};
        MKHOOK(); pg8::gemm_phase<EpiMerge, SchedMerge, ConvHook>(ring, F.wave, pg8::Gemm{8192u, 8192u}, S, E, HK, 0);
    } SEAM(7);
    if (IN(8)) REP(8) { F.ws = WSP(); unsigned char* const ws = F.ws; (void)ws;
        SchedGrid S{(const char*)(ws + WS_MRG), (const char*)(ws + WS_WOUT), 4096u, 4096u, 32, 8, F.G, F.bx, 32};
        EpiX1 E{INP(0), (float*)(ws + WS_X1)};
        MKHOOK(); pg8::gemm_phase<EpiX1, SchedGrid, ConvHook>(ring, F.wave, pg8::Gemm{4096u, 4096u}, S, E, HK, 0);
    } SEAM(8);
    if (IN(9)) REP(9) { F.ws = WSP(); unsigned char* const ws = F.ws; (void)ws; p8_router(F); MKHOOK(); HK.run(1000, lane_id()); } SEAM(9);
    if (IN(10)) REP(10) { F.ws = WSP(); unsigned char* const ws = F.ws; (void)ws;
        moe_table(F, tab, 16);
        { SchedMoe2 S{(const char*)(ws + WS_XS), (const char*)(ws + WS_HA), (const char*)(ws + WS_WGU), (const char*)(ws + WS_WD), tab, F.G, F.bx, nullptr, nullptr, 0};
          EpiGU E{INP(18), (unsigned char*)(ws + WS_HA)};
          pg8::gemm_phase<EpiGU, SchedMoe2, NoHook, true>(ring, F.wave, pg8::Gemm{2048u, 2048u}, S, E); }
    } SEAM(10);
    if (IN(11)) REP(11) { F.ws = WSP(); unsigned char* const ws = F.ws; (void)ws;
        { SchedMoe2 S{(const char*)(ws + WS_XS), (const char*)(ws + WS_HA), (const char*)(ws + WS_WGU), (const char*)(ws + WS_WD), tab, F.G, F.bx, nullptr, nullptr, 1};
          EpiDown E{INP(20), (bf16*)(ws + WS_YE)};
          pg8::gemm_phase<EpiDown, SchedMoe2, NoHook, true>(ring, F.wave, pg8::Gemm{2048u, 2048u}, S, E); }
    }
    SEAM(11);
    if (IN(12)) REP(12) { F.ws = WSP(); unsigned char* const ws = F.ws; (void)ws; p11_combine(F); }
#undef IN
#undef SEAM
}

extern "C" void kernel_launch(void* const* d_in, const int* in_sizes, int n_in, void* d_out, int out_size, void* d_ws, size_t ws_size, hipStream_t stream) {
    static int grid = 0;
    if (grid == 0) {
        if (n_in != 22 || out_size != T * D || ws_size < WS_END) { fprintf(stderr, "kernel_launch: unexpected shapes (n_in %d out %d ws %zu need %zu)\n", n_in, out_size, ws_size, (size_t)WS_END); grid = -1; return; }
        int dev = 0, cus = 0, per_cu = 0;
        if (hipGetDevice(&dev) != hipSuccess || hipDeviceGetAttribute(&cus, hipDeviceAttributeMultiprocessorCount, dev) != hipSuccess) { grid = -1; return; }
        if (hipFuncSetAttribute((const void*)mk_fwd, hipFuncAttributeMaxDynamicSharedMemorySize, LDS_BYTES) != hipSuccess) { fprintf(stderr, "kernel_launch: hipFuncSetAttribute failed\n"); grid = -1; return; }
        if (hipOccupancyMaxActiveBlocksPerMultiprocessor(&per_cu, (const void*)mk_fwd, NTHR, LDS_BYTES) != hipSuccess || per_cu < 1) fprintf(stderr, "kernel_launch: occupancy query says %d\n", per_cu);
        (void)hipGetLastError();
        grid = cus;
    }
    if (grid < 0) return;
    (void)in_sizes;
    hipMemsetAsync((char*)d_ws + WS_CTL, 0, CTL_ZERO_BYTES, stream);
    Args a{};
    for (int i = 0; i < 22; ++i) a.in[i] = (const float*)d_in[i];
    a.out = (float*)d_out; a.ws = (unsigned char*)d_ws;
    if (MK_N_LAUNCHES == 1) { a.ph_lo = 0; a.ph_hi = N_PHASES; a.li = 0; hipLaunchKernelGGL(mk_fwd, dim3(grid), dim3(NTHR), LDS_BYTES, stream, a); }
    else { for (int p = 0; p < N_PHASES; ++p) { a.ph_lo = p; a.ph_hi = p + 1; a.li = p; hipLaunchKernelGGL(mk_fwd, dim3(grid), dim3(NTHR), LDS_BYTES, stream, a); } }
}
```

```cpp
#include <hip/hip_runtime.h>
#include <cstdio>
#include <cstdint>

#ifndef MK_N_LAUNCHES
#define MK_N_LAUNCHES 1
#endif

#define GAS __attribute__((address_space(1)))
#define LAS __attribute__((address_space(3)))
typedef unsigned short bf16;
typedef short bf16x8 __attribute__((ext_vector_type(8)));
typedef short bf16x16 __attribute__((ext_vector_type(16)));
typedef int i32x8 __attribute__((ext_vector_type(8)));
typedef int i32x4 __attribute__((ext_vector_type(4)));
typedef float f32x4 __attribute__((ext_vector_type(4)));
typedef float f32x2 __attribute__((ext_vector_type(2)));
typedef unsigned u32x4 __attribute__((ext_vector_type(4)));
typedef unsigned u32x2 __attribute__((ext_vector_type(2)));

constexpr int D = 2048, NB = 4, SEQ = 2048, T = NB * SEQ;
constexpr int INC = 16392;
constexpr int NH = 4, DH = 512, NE = 32, TOPK = 4, FF = 2048, CAP = 8192;
constexpr int N_BF16_TILES = 40, N_FP8_TILES = 24;
constexpr float EPS = 1e-6f;
constexpr int NWAVES = 8, NTHR = 512;

constexpr size_t MiB = 1u << 20;
constexpr size_t WS_CTL = 0, CTL_ZERO_BYTES = 128 * 1024;
constexpr size_t CTLB_ECNT = 32 * 1024;
constexpr size_t CTLB_TMO = 48 * 1024;
constexpr size_t CTLB_HCNT = 64 * 1024;
constexpr size_t WS_G8 = 1 * MiB;
constexpr size_t WS_AS = WS_G8 + 512 * 1024;
constexpr size_t WS_MT = WS_AS + 128 * 1024;
constexpr size_t WS_BM = WS_MT + 128 * 1024;
constexpr size_t WS_SLOT = 2 * MiB;
constexpr size_t WS_WBD = 3 * MiB;
constexpr size_t WS_WIN = 4 * MiB;
constexpr size_t WS_PAM = WS_WIN + 64 * MiB;
constexpr size_t WS_WOUT = WS_PAM + 16 * MiB;
constexpr size_t WS_WGU = WS_WOUT + 8 * MiB;
constexpr size_t WS_WD = WS_WGU + 512 * MiB;
constexpr size_t WS_H = WS_WD + 256 * MiB;
constexpr size_t WS_UG = WS_H + 32 * MiB;
constexpr size_t WS_VGT = WS_UG + 32 * MiB;
constexpr size_t WS_QKR = WS_VGT + 32 * MiB;
constexpr size_t WS_QKC = WS_QKR + 64 * MiB;
constexpr size_t WS_VMT = WS_QKC + 64 * MiB;
constexpr size_t WS_OG = WS_VMT + 32 * MiB;
constexpr size_t WS_GA = WS_OG + 32 * MiB;
constexpr size_t WS_GM = WS_GA + 32 * MiB;
constexpr size_t WS_P = WS_GM + 32 * MiB;
constexpr size_t WS_HM = WS_P + 128 * MiB;
constexpr size_t WS_Y = WS_HM + 32 * MiB;
constexpr size_t WS_MRG = WS_Y + 64 * MiB;
constexpr size_t WS_X1 = WS_MRG + 32 * MiB;
constexpr size_t WS_XS = WS_X1 + 64 * MiB;
constexpr size_t WS_HA = WS_XS + 512 * MiB;
constexpr size_t WS_YE = WS_XS + 1024 * MiB;
constexpr size_t WS_DENP = WS_YE + 1024 * MiB;
constexpr size_t WS_VPART = WS_DENP + 4 * MiB;
constexpr size_t WS_SSQP = WS_VPART + 2 * MiB;
constexpr size_t WS_H8 = WS_SSQP + 1 * MiB;
constexpr size_t WS_WIN8 = WS_H8 + 16 * MiB;
constexpr size_t WS_END = WS_WIN8 + 12 * MiB;

constexpr int RING_BYTES = 131072;
constexpr int MISC_OFF = RING_BYTES;
constexpr int LDS_BYTES = 147456;

#define LDS_WAIT() asm volatile("s_waitcnt lgkmcnt(0)" ::: "memory")
#define VM_WAIT() asm volatile("s_waitcnt vmcnt(0)" ::: "memory")

__device__ __forceinline__ unsigned f2bf(float f) { unsigned u = __builtin_bit_cast(unsigned, f); return (u + 0x7fffu + ((u >> 16) & 1u)) >> 16; }
__device__ __forceinline__ unsigned pk2(float lo, float hi) { return f2bf(lo) | (f2bf(hi) << 16); }
__device__ __forceinline__ float bflo(unsigned w) { return __builtin_bit_cast(float, w << 16); }
__device__ __forceinline__ float bfhi(unsigned w) { return __builtin_bit_cast(float, w & 0xffff0000u); }
__device__ __forceinline__ float bf2f(bf16 b) { return __builtin_bit_cast(float, ((unsigned)b) << 16); }
__device__ __forceinline__ unsigned cvt_pk_bf16(float lo, float hi) { unsigned r; asm volatile("v_cvt_pk_bf16_f32 %0, %1, %2" : "=v"(r) : "v"(lo), "v"(hi)); return r; }
__device__ __forceinline__ unsigned pk4_fp8(float a, float b, float c, float d) {
    a = __builtin_amdgcn_fmed3f(a, -448.f, 448.f); b = __builtin_amdgcn_fmed3f(b, -448.f, 448.f); c = __builtin_amdgcn_fmed3f(c, -448.f, 448.f); d = __builtin_amdgcn_fmed3f(d, -448.f, 448.f);
    int r = __builtin_amdgcn_cvt_pk_fp8_f32(a, b, 0, false); r = __builtin_amdgcn_cvt_pk_fp8_f32(c, d, r, true); return (unsigned)r; }
__device__ __forceinline__ float fast_exp(float x) { return __builtin_amdgcn_exp2f(x * 1.44269504089f); }
__device__ __forceinline__ float sigmoidf_(float x) { return __builtin_amdgcn_rcpf(1.0f + fast_exp(-x)); }
__device__ __forceinline__ int lane_id() { int l; asm volatile("v_mbcnt_lo_u32_b32 %0, -1, 0\n\tv_mbcnt_hi_u32_b32 %0, -1, %0" : "=v"(l)); return l; }
__device__ __forceinline__ const char* uniform_ptr(const char* p) {
    const unsigned long long v = (unsigned long long)p; const unsigned lo = (unsigned)__builtin_amdgcn_readfirstlane((int)(unsigned)v), hi = (unsigned)__builtin_amdgcn_readfirstlane((int)(unsigned)(v >> 32));
    return (const char*)(((unsigned long long)hi << 32) | lo); }
__device__ __forceinline__ float wave_sum(float v) {
#pragma unroll
    for (int o = 1; o < 64; o <<= 1) v += __shfl_xor(v, o);
    return v;
}

#define XB_TMO      128
#define XB_XCNT(j)  (256  + 64 * (j))
#define XB_XSUB(j)  (1280 + 64 * (j))
#define XB_XGEN(j)  (2304 + 64 * (j))
#define XB_TOP      3328
#define XB_TOPGEN   3392
#define XCD_BAR_WORDS 3456
#define XB_SPIN_CAP (1u << 18)
__device__ __forceinline__ unsigned xb_ld(unsigned* p)              { return __hip_atomic_load(p, __ATOMIC_RELAXED, __HIP_MEMORY_SCOPE_AGENT); }
__device__ __forceinline__ unsigned xb_add(unsigned* p, unsigned v) { return __hip_atomic_fetch_add(p, v, __ATOMIC_RELAXED, __HIP_MEMORY_SCOPE_AGENT); }
__device__ __forceinline__ unsigned xb_xcc_id() { return (unsigned)__builtin_amdgcn_s_getreg((3 << 11) | 20) & 0xFu; }
#define XB_SPIN(cond, bar) do { unsigned _sp = 0; while (cond) { __builtin_amdgcn_s_sleep(1); \
    if ((++_sp & 255u) == 0u) { if (xb_ld(&(bar)[XB_TMO])) break; if (_sp > XB_SPIN_CAP) { atomicAdd(&(bar)[XB_TMO], 1u); break; } } } } while (0)
struct XcdBarrier { unsigned* bar; unsigned x; volatile LAS unsigned* st; unsigned G; };
__device__ __forceinline__ XcdBarrier xcd_barrier_post(unsigned* bar, volatile LAS unsigned* st, bool leader) {
    XcdBarrier b; b.bar = bar; b.x = xb_xcc_id(); b.st = st; b.G = 0u;
    if (leader) (void)xb_add(&bar[XB_XCNT(b.x)], 1u);
    return b;
}
__device__ __forceinline__ void xcd_barrier_complete(unsigned* bar, unsigned x, unsigned& nloc, unsigned& nx, const unsigned G) {
    unsigned sum, cnt, mine, sp = 0u;
    for (;;) {
        sum = 0u; cnt = 0u; mine = 0u;
#pragma unroll
        for (unsigned j = 0; j < 16; ++j) { const unsigned c = xb_ld(&bar[XB_XCNT(j)]); sum += c; cnt += (c > 0u) ? 1u : 0u; mine = (j == x) ? c : mine; }
        if (sum == G) break;
        __builtin_amdgcn_s_sleep(1);
        if ((++sp & 255u) == 0u) { if (xb_ld(&bar[XB_TMO])) break; if (sp > XB_SPIN_CAP) { atomicAdd(&bar[XB_TMO], 1u); break; } }
    }
    nloc = mine > 0u ? mine : 1u; nx = cnt > 0u ? cnt : 1u;
}
__device__ __forceinline__ void xcd_barrier(const XcdBarrier& b, int wave) {
    asm volatile("s_waitcnt vmcnt(0)" ::: "memory");
    __syncthreads();
    if (wave == 0 && lane_id() == 0) {
        unsigned* bar = b.bar;
        __builtin_amdgcn_s_waitcnt(0);
        unsigned nloc = b.st[0], nx = b.st[1];
        if (nloc == 0u) { xcd_barrier_complete(bar, b.x, nloc, nx, b.G); b.st[0] = nloc; b.st[1] = nx; }
        const unsigned old = xb_add(&bar[XB_XSUB(b.x)], 1u);
        const unsigned gen = old / nloc;
        if (old + 1u == (gen + 1u) * nloc) {
            __builtin_amdgcn_fence(__ATOMIC_RELEASE, "agent");
            asm volatile("s_waitcnt vmcnt(0)" ::: "memory");
            const unsigned og = xb_add(&bar[XB_TOP], 1u);
            const unsigned tg = og / nx;
            if (og + 1u == (tg + 1u) * nx) xb_add(&bar[XB_TOPGEN], 1u);
            else XB_SPIN(xb_ld(&bar[XB_TOPGEN]) == tg, bar);
            __builtin_amdgcn_fence(__ATOMIC_ACQUIRE, "agent");
            xb_add(&bar[XB_XGEN(b.x)], 1u);
            asm volatile("s_waitcnt vmcnt(0)" ::: "memory");
        } else {
            XB_SPIN(xb_ld(&bar[XB_XGEN(b.x)]) == gen, bar);
            __builtin_amdgcn_fence(__ATOMIC_ACQUIRE, "agent");
            asm volatile("s_waitcnt vmcnt(0)" ::: "memory");
        }
    }
    __syncthreads();
}


constexpr int CONV_ITEMS = 98304;
constexpr int CONV_ITEMS_PER_WAVE = 1 << 20;
constexpr int CONV_P1_PER_WAVE = 44;
constexpr int CONV_POOL5 = 2048 * CONV_P1_PER_WAVE;
constexpr unsigned CONV_P5_N = 0xB8642100u; constexpr unsigned long long CONV_P5_PRE = 0x150D070301000000ull;
static_assert(CONV_POOL5 + 256 * 32 == CONV_ITEMS, "pool sizes");
struct ConvHook {
    const float* wgu; const float* wd; unsigned char* wguT; unsigned char* wdT; volatile LAS int* cnt; int gw, nw;
    __device__ __forceinline__ void load_item(int it, int lane, f32x4 (&v)[16], unsigned char*& dst) const {
        const int kg = lane >> 3, ng = lane & 7; const float* s; size_t pitch;
        if (it < 65536) { const int e = it >> 11, rr = it & 2047, kb = rr >> 7, nb = rr & 127, n0 = nb * 32, nn = n0 & 2047, drow = (nn >> 7) * 256 + (n0 >= 2048 ? 128 : 0) + (nn & 127);
            s = wgu + (size_t)e * 2048 * 4096 + (size_t)(kb * 128 + kg * 16) * 4096 + n0 + 4 * ng; pitch = 4096;
            dst = wguT + (size_t)e * 4096 * 2048 + (size_t)(drow + 4 * ng) * 2048 + kb * 128 + kg * 16; }
        else { const int i2 = it - 65536, e = i2 >> 10, rr = i2 & 1023, kb = rr >> 6, nb = rr & 63, n0 = nb * 32;
            s = wd + (size_t)e * 2048 * 2048 + (size_t)(kb * 128 + kg * 16) * 2048 + n0 + 4 * ng; pitch = 2048;
            dst = wdT + (size_t)e * 2048 * 2048 + (size_t)(n0 + 4 * ng) * 2048 + kb * 128 + kg * 16; }
#pragma unroll
        for (int i = 0; i < 16; ++i) v[i] = __builtin_nontemporal_load((const f32x4*)(s + (size_t)i * pitch));
    }
    __device__ __forceinline__ void store_item(const f32x4 (&v)[16], unsigned char* dst) const {
#pragma unroll
        for (int c = 0; c < 4; ++c) { u32x4 o;
            o.x = pk4_fp8(v[0][c] * 64.f, v[1][c] * 64.f, v[2][c] * 64.f, v[3][c] * 64.f); o.y = pk4_fp8(v[4][c] * 64.f, v[5][c] * 64.f, v[6][c] * 64.f, v[7][c] * 64.f);
            o.z = pk4_fp8(v[8][c] * 64.f, v[9][c] * 64.f, v[10][c] * 64.f, v[11][c] * 64.f); o.w = pk4_fp8(v[12][c] * 64.f, v[13][c] * 64.f, v[14][c] * 64.f, v[15][c] * 64.f);
            *(u32x4*)(dst + (size_t)c * 2048) = o; }
    }
    template <class IT> __device__ __forceinline__ void run_range(int j, const int jend, int lane, IT item) const {
        if (j >= jend) return;
        f32x4 v0[16], v1[16], v2[16]; unsigned char *d0 = nullptr, *d1 = nullptr, *d2 = nullptr;
        load_item(item(j), lane, v0, d0); if (j + 1 < jend) load_item(item(j + 1), lane, v1, d1); if (j + 2 < jend) load_item(item(j + 2), lane, v2, d2);
        for (; j < jend; j += 3) {
            store_item(v0, d0); if (j + 3 < jend) load_item(item(j + 3), lane, v0, d0);
            if (j + 1 < jend) { store_item(v1, d1); if (j + 4 < jend) load_item(item(j + 4), lane, v1, d1); }
            if (j + 2 < jend) { store_item(v2, d2); if (j + 5 < jend) load_item(item(j + 5), lane, v2, d2); }
        }
    }
    __device__ __forceinline__ void run(int nitems, int lane) const {
        const int j = *cnt; const int jown = (nw == 2048) ? CONV_P1_PER_WAVE : (CONV_ITEMS - gw + nw - 1) / nw; const int jend = (j + nitems < jown) ? j + nitems : jown;
        if (j >= jend) return;
        const int g_ = gw, n_ = nw; run_range(j, jend, lane, [g_, n_](int jj) { return g_ + n_ * jj; });
        *cnt = jend;
    }
};
struct ConvPool {
    ConvHook h; int first, n;
    __device__ __forceinline__ void run(int, int lane) const { const int f_ = first; h.run_range(0, n, lane, [f_](int jj) { return f_ + jj; }); }
};
struct NoHook { __device__ __forceinline__ void run(int, int) const {} };

namespace pg8 {
constexpr int BM = 256, BK = 64, HALF = 128, HTB = HALF * BK * 2, STAGE_BYTES = 8 * HTB, NXCD = 8, WGM = 8;
__host__ __device__ __forceinline__ int lds_byte(int r, int c) { const int st = (r >> 4) * 2 + (c >> 5), rr = r & 15, cc = c & 31, ob = rr * 64 + cc * 2; return st * 1024 + (ob ^ (((ob >> 9) & 1) << 5)); }
__host__ __device__ __forceinline__ void stage_rc(int b, int& R, int& C) { const int st = b / 1024, sb = b % 1024, swz = sb ^ (((sb >> 9) & 1) << 5); R = (st >> 1) * 16 + swz / 64; C = (st & 1) * 32 + (swz % 64) / 2; }
__host__ __device__ __forceinline__ int perm32(int rho) { const int n = rho >> 4, i = rho & 15; return 8 * (i >> 2) + 4 * n + (i & 3); }

struct Unit { const char* a; const char* b; int nt; int pm, pn, z; };
struct Gemm { unsigned lda, ldb; };

__device__ __forceinline__ void tile_order(int L, int nM, int nN, int& pm, int& pn) {
    const int nwg = nM * nN; int wgid = L;
    { const int q = nwg / NXCD, r = nwg % NXCD, xcd = wgid % NXCD, off = wgid / NXCD; wgid = (xcd < r ? xcd * (q + 1) : r * (q + 1) + (xcd - r) * q) + off; }
    const int nig = WGM * nN, gid = wgid / nig, fm = gid * WGM, gsz = (nM - fm) < WGM ? (nM - fm) : WGM;
    pm = fm + ((wgid % nig) % gsz); pn = (wgid % nig) / gsz;
}

template <class Epi, class Sched, class Hook = NoHook, bool FP8 = false, bool ALIGN_EPI = true, bool SP2 = true>
__device__ __forceinline__ void gemm_phase(LAS unsigned char* lds, const int wid, const Gemm g, const Sched& S, const Epi& E, const Hook& H = Hook(), const int hook_rounds = 0, const int hook_slot = -1) {
    const int lane = lane_id(), tid = wid * 64 + lane, wr = wid >> 2, wc = wid & 3;
    unsigned voffA[2], voffB[2];
#pragma unroll
    for (int i = 0; i < 2; ++i) { int R, C; stage_rc(tid * 16 + i * 8192, R, C); const int Rb = Epi::PERM ? ((R & ~31) + perm32(R & 31)) : R;
        voffA[i] = (unsigned)R * g.lda + (unsigned)C * 2u; voffB[i] = (unsigned)Rb * g.ldb + (unsigned)C * 2u; }
    const size_t kstep = (size_t)(BK * 2);
    const size_t hstepA = (size_t)HALF * g.lda, hstepB = (size_t)HALF * g.ldb;
    const unsigned ldsw = (unsigned)wid * 1024u;
    const unsigned ldsbase = (unsigned)(size_t)lds;
    const int aoff = lds_byte(wr * 64 + (lane & 15), (lane >> 4) * 8), boff = lds_byte(wc * 32 + (lane & 15), (lane >> 4) * 8);
#define PG8_SA(b, h) (((b) * 2 + (h)) * HTB)
#define PG8_SB(b, h) ((4 + (b) * 2 + (h)) * HTB)
#define PG8_STAGE(bufoff, gbase, voff) do { unsigned _keep; \
        asm volatile("s_mov_b32 %0, m0\n\ts_mov_b32 m0, %3\n\ts_nop 0\n\tglobal_load_lds_dwordx4 %1, %4\n\ts_bitset1_b32 m0, 13\n\ts_nop 0\n\tglobal_load_lds_dwordx4 %2, %4\n\ts_mov_b32 m0, %0" \
            : "=&s"(_keep) : "v"((voff)[0]), "v"((voff)[1]), "s"(ldsbase + (unsigned)(bufoff) + ldsw), "s"(uniform_ptr((const char*)(gbase))) : "memory"); } while (0)
#define PG8_LDA(dst, b, h) do { _Pragma("unroll") for (int m = 0; m < 4; ++m) _Pragma("unroll") for (int k = 0; k < 2; ++k) dst[m][k] = *(const LAS bf16x8*)(lds + PG8_SA(b, h) + aoff + m * 2048 + k * 1024); } while (0)
#define PG8_LDB(dst, b, h) do { _Pragma("unroll") for (int n = 0; n < 2; ++n) _Pragma("unroll") for (int k = 0; k < 2; ++k) dst[n][k] = *(const LAS bf16x8*)(lds + PG8_SB(b, h) + boff + n * 2048 + k * 1024); } while (0)
#define PG8_MMA(ai, bj, At, Bt) do { __builtin_amdgcn_s_setprio(1); _Pragma("unroll") for (int m = 0; m < 4; ++m) _Pragma("unroll") for (int n = 0; n < 2; ++n) { \
        if constexpr (FP8) { const i32x8 _b8 = __builtin_shufflevector(__builtin_bit_cast(i32x4, Bt[n][0]), __builtin_bit_cast(i32x4, Bt[n][1]), 0, 1, 2, 3, 4, 5, 6, 7); \
                const i32x8 _a8 = __builtin_shufflevector(__builtin_bit_cast(i32x4, At[m][0]), __builtin_bit_cast(i32x4, At[m][1]), 0, 1, 2, 3, 4, 5, 6, 7); \
                asm volatile("v_mfma_scale_f32_16x16x128_f8f6f4 %0, %1, %2, %0, %3, %4 op_sel_hi:[0,0,0]" : "+v"(acc[ai][bj][m][n]) : "v"(_b8), "v"(_a8), "v"(sc_w), "v"(sc_x)); }   \
        else { _Pragma("unroll") for (int k = 0; k < 2; ++k) acc[ai][bj][m][n] = __builtin_amdgcn_mfma_f32_16x16x32_bf16(Bt[n][k], At[m][k], acc[ai][bj][m][n], 0, 0, 0); } } __builtin_amdgcn_s_setprio(0); } while (0)
#define PG8_WAIT_V(n) asm volatile("s_waitcnt vmcnt(" #n ")" ::: "memory")
#define PG8_WAIT_L(n) asm volatile("s_waitcnt lgkmcnt(" #n ")" ::: "memory")
#define PG8_BAR __builtin_amdgcn_s_barrier()
#define PG8_SCHED __builtin_amdgcn_sched_barrier(0)
    const int sc_w = 0x79797979, sc_x = 0x7f7f7f7f; (void)sc_w; (void)sc_x;
    Unit cur, nxt; int ui = 0;
    if (!S.next(0, cur)) return;
    f32x4 acc[2][2][4][2];
#pragma unroll
    for (int a = 0; a < 2; ++a)
#pragma unroll
        for (int b = 0; b < 2; ++b)
#pragma unroll
            for (int m = 0; m < 4; ++m)
#pragma unroll
                for (int n = 0; n < 2; ++n) acc[a][b][m][n] = (f32x4){0.f, 0.f, 0.f, 0.f};
    bf16x8 At[4][2], B0[2][2], B1[2][2];
    const char* cA = cur.a; const char* cB = cur.b;
    S.ready(cur, wid);
    if constexpr (SP2) {
        PG8_STAGE(PG8_SB(0, 0), cB, voffB); PG8_STAGE(PG8_SB(0, 1), cB + hstepB, voffB); PG8_STAGE(PG8_SA(0, 0), cA, voffA); PG8_STAGE(PG8_SA(0, 1), cA + hstepA, voffA);
        if (wr == 1) PG8_BAR;
        PG8_WAIT_V(2); PG8_BAR;
        PG8_STAGE(PG8_SB(1, 0), cB + kstep, voffB); PG8_STAGE(PG8_SA(1, 0), cA + kstep, voffA); PG8_STAGE(PG8_SB(1, 1), cB + hstepB + kstep, voffB);
        PG8_WAIT_V(6); PG8_BAR;
    } else {
        PG8_STAGE(PG8_SB(0, 0), cB, voffB); PG8_STAGE(PG8_SA(0, 0), cA, voffA); PG8_STAGE(PG8_SB(0, 1), cB + hstepB, voffB); PG8_STAGE(PG8_SA(0, 1), cA + hstepA, voffA);
        if (wr == 1) PG8_BAR;
        PG8_WAIT_V(4); PG8_BAR;
        PG8_STAGE(PG8_SB(1, 0), cB + kstep, voffB); PG8_STAGE(PG8_SA(1, 0), cA + kstep, voffA); PG8_STAGE(PG8_SB(1, 1), cB + hstepB + kstep, voffB);
        PG8_WAIT_V(6); PG8_BAR;
    }
    for (;;) {
        const bool has_next = S.next(ui + 1, nxt);
        const char* nA = has_next ? nxt.a : cA; const char* nB = has_next ? nxt.b : cB;
        const int nt = cur.nt;
#pragma unroll 1
        for (int t = 0; t < nt; t += 2) {
            const bool last = (t == nt - 2);
            if (last && has_next) S.ready(nxt, wid);
            const char* a1 = cA + (size_t)(t + 1) * kstep;
            const char* a2 = last ? nA : cA + (size_t)(t + 2) * kstep; const char* b2 = last ? nB : cB + (size_t)(t + 2) * kstep;
            const char* a3 = a2 + kstep; const char* b3 = b2 + kstep;
            if constexpr (SP2) {
            PG8_LDB(B0, 0, 0); PG8_LDB(B1, 0, 1); PG8_SCHED; PG8_LDA(At, 0, 0); PG8_STAGE(PG8_SA(1, 1), a1 + hstepA, voffA);
            PG8_WAIT_V(8); PG8_WAIT_L(0); PG8_BAR; PG8_MMA(0, 0, At, B0); PG8_MMA(0, 1, At, B1); PG8_BAR; PG8_SCHED;
            PG8_LDA(At, 0, 1); PG8_STAGE(PG8_SB(0, 0), b2, voffB); PG8_STAGE(PG8_SB(0, 1), b2 + hstepB, voffB); PG8_STAGE(PG8_SA(0, 0), a2, voffA);
            PG8_WAIT_V(8); PG8_WAIT_L(0); PG8_BAR; PG8_MMA(1, 0, At, B0); PG8_MMA(1, 1, At, B1); PG8_BAR; PG8_SCHED;
            PG8_LDB(B0, 1, 0); PG8_LDB(B1, 1, 1); PG8_SCHED; PG8_LDA(At, 1, 0); PG8_STAGE(PG8_SA(0, 1), a2 + hstepA, voffA);
            PG8_WAIT_V(8); PG8_WAIT_L(0); PG8_BAR; PG8_MMA(0, 0, At, B0); PG8_MMA(0, 1, At, B1); PG8_BAR; PG8_SCHED;
            PG8_LDA(At, 1, 1); PG8_STAGE(PG8_SB(1, 0), b3, voffB); PG8_STAGE(PG8_SB(1, 1), b3 + hstepB, voffB); PG8_STAGE(PG8_SA(1, 0), a3, voffA);
            PG8_WAIT_V(8); PG8_WAIT_L(0); PG8_BAR; PG8_MMA(1, 0, At, B0); PG8_MMA(1, 1, At, B1); PG8_BAR; PG8_SCHED;
            } else {
            PG8_LDB(B0, 0, 0); PG8_SCHED; PG8_LDA(At, 0, 0); PG8_STAGE(PG8_SA(1, 1), a1 + hstepA, voffA);
            PG8_WAIT_L(8); PG8_BAR; PG8_WAIT_L(0); PG8_MMA(0, 0, At, B0); PG8_BAR; PG8_SCHED;
            PG8_LDB(B1, 0, 1); PG8_STAGE(PG8_SB(0, 0), b2, voffB);
            PG8_BAR; PG8_WAIT_L(0); PG8_MMA(0, 1, At, B1); PG8_BAR;
            PG8_LDA(At, 0, 1); PG8_STAGE(PG8_SA(0, 0), a2, voffA);
            PG8_BAR; PG8_WAIT_L(0); PG8_MMA(1, 0, At, B0); PG8_BAR; PG8_SCHED;
            PG8_STAGE(PG8_SB(0, 1), b2 + hstepB, voffB);
            PG8_WAIT_V(6); PG8_BAR; PG8_MMA(1, 1, At, B1); PG8_BAR;
            PG8_LDB(B0, 1, 0); PG8_SCHED; PG8_LDA(At, 1, 0); PG8_STAGE(PG8_SA(0, 1), a2 + hstepA, voffA);
            PG8_WAIT_L(8); PG8_BAR; PG8_WAIT_L(0); PG8_MMA(0, 0, At, B0); PG8_BAR; PG8_SCHED;
            PG8_LDB(B1, 1, 1); PG8_STAGE(PG8_SB(1, 0), b3, voffB);
            PG8_BAR; PG8_WAIT_L(0); PG8_MMA(0, 1, At, B1); PG8_BAR;
            PG8_LDA(At, 1, 1); PG8_STAGE(PG8_SA(1, 0), a3, voffA);
            PG8_BAR; PG8_WAIT_L(0); PG8_MMA(1, 0, At, B0); PG8_BAR; PG8_SCHED;
            PG8_STAGE(PG8_SB(1, 1), b3 + hstepB, voffB);
            PG8_WAIT_V(6); PG8_BAR; PG8_MMA(1, 1, At, B1); PG8_BAR;
            }
        }
        if constexpr (ALIGN_EPI) { if (wr == 0) PG8_BAR; }
        if constexpr (FP8) { asm volatile("s_nop 15\n\ts_nop 15"); }
        const int ln_o = lane_id();
        const bool keep = E(acc, cur, wr, wc, ln_o & 15, ln_o >> 4);
        if (!keep) {
            if (hook_slot == -1 || ui == hook_slot || (hook_slot == -2 && !has_next)) H.run(hook_rounds, ln_o);
#pragma unroll
            for (int a = 0; a < 2; ++a)
#pragma unroll
                for (int b = 0; b < 2; ++b)
#pragma unroll
                    for (int m = 0; m < 4; ++m)
#pragma unroll
                        for (int n = 0; n < 2; ++n) acc[a][b][m][n] = (f32x4){0.f, 0.f, 0.f, 0.f};
        }
        if (!has_next) break;
        cur = nxt; cA = nA; cB = nB; ++ui;
        if constexpr (ALIGN_EPI) { if (wr == 1) PG8_BAR; }
    }
    PG8_WAIT_V(0);
    if constexpr (!ALIGN_EPI) { if (wr == 0) PG8_BAR; }
    PG8_BAR;
#undef PG8_SA
#undef PG8_SB
#undef PG8_STAGE
#undef PG8_LDA
#undef PG8_LDB
#undef PG8_MMA
#undef PG8_WAIT_V
#undef PG8_WAIT_L
#undef PG8_BAR
#undef PG8_SCHED
}

__device__ __forceinline__ f32x2 gelu_pk(f32x2 v) {
    const f32x2 av = __builtin_elementwise_abs(v), d = av * 0.2316418882f + 1.0f;
    f32x2 t; t.x = __builtin_amdgcn_rcpf(d.x); t.y = __builtin_amdgcn_rcpf(d.y);
    f32x2 q = t * 0.5307027145f + (-0.7265760135f); q = q * t + 0.7107068705f; q = q * t + (-0.142248368f); q = q * t + 0.127414796f; q = q * t;
    const f32x2 s = (v * v) * (-0.72134752044f);
    f32x2 e; e.x = __builtin_amdgcn_exp2f(s.x); e.y = __builtin_amdgcn_exp2f(s.y);
    const f32x2 m = v * (q * e), r = v - m;
    f32x2 o; o.x = v.x < 0.f ? m.x : r.x; o.y = v.y < 0.f ? m.y : r.y; return o;
}
}
using pg8::Unit;

struct SchedGrid {
    const char* A; const char* B; unsigned lda, ldb; int nM, nN, G, c, nt, pn_off = 0;
    __device__ __forceinline__ void ready(const Unit&, int) const {}
    __device__ __forceinline__ bool next(int i, Unit& u) const {
        const int L = i * G + c; if (L >= nM * nN) return false;
        int pm, pn; pg8::tile_order(L, nM, nN, pm, pn);
        u.a = A + (size_t)pm * 256 * lda; u.b = B + (size_t)pn * 256 * ldb; u.nt = nt; u.pm = pm; u.pn = pn + pn_off; u.z = 0; return true;
    }
};
struct SchedMerge {
    const char* A; const char* B; int G, c;
    __device__ __forceinline__ void ready(const Unit&, int) const {}
    __device__ __forceinline__ bool next(int i, Unit& u) const {
        const int L = (i >> 1) * G + c, half = i & 1; if (L >= 32 * 8) return false;
        int pm, pn; pg8::tile_order(L, 32, 8, pm, pn);
        u.a = A + (size_t)pm * 256 * 8192 + half * 4096; u.b = B + (size_t)pn * 256 * 8192 + half * 4096; u.nt = 32; u.pm = pm; u.pn = pn; u.z = half; return true;
    }
};
struct SchedSgu {
    const char* Wbd; const char* VgT; int G, c;
    __device__ __forceinline__ void ready(const Unit&, int) const {}
    __device__ __forceinline__ bool next(int i, Unit& u) const {
        const int L = i * G + c; if (L >= 256) return false;
        const int bp = L >> 3, g = L & 7, b = bp >> 3, pair = bp & 7;
        u.a = Wbd + (size_t)g * 256 * 512; u.b = VgT + ((size_t)(b * 2048 + g * 256) * 2048 + pair * 256) * 2; u.nt = 4; u.pm = bp; u.pn = g; u.z = 0; return true;
    }
};
struct SchedQK {
    const char* QKc; int G, c;
    __device__ __forceinline__ void ready(const Unit&, int) const {}
    __device__ __forceinline__ bool next(int i, Unit& u) const {
        int bh, tri;
        if ((G & 7) == 0) { const int x = c & 7, q = c >> 3, W = G >> 3; const int L = i * W + q; if (L >= 72) return false; bh = x + 8 * (L / 36); tri = L % 36; }
        else { const int L = i * G + c; if (L >= 16 * 36) return false; bh = L / 36; tri = L % 36; }
        int pm = 0; while ((pm + 1) * (pm + 2) / 2 <= tri) ++pm; const int pn = tri - pm * (pm + 1) / 2;
        const int b = bh >> 2, h = bh & 3;
        u.a = QKc + ((size_t)(b * 2048 + pm * 256) * 4096 + h * 512) * 2; u.b = QKc + ((size_t)(b * 2048 + pn * 256) * 4096 + 2048 + h * 512) * 2;
        u.nt = 8; u.pm = pm; u.pn = pn; u.z = bh; return true;
    }
};
struct SchedPV {
    const char* P; const char* VmT; int G, c;
    __device__ __forceinline__ void ready(const Unit&, int) const {}
    __device__ __forceinline__ bool next(int i, Unit& u) const {
        const int L = i * G + c; if (L >= 256) return false;
        const int bh = L & 15, r = L >> 4, pm = 7 - (r >> 1), pn = r & 1, b = bh >> 2, h = bh & 3;
        u.a = P + ((size_t)(bh * 2048 + pm * 256) * 2048) * 2; u.b = VmT + ((size_t)(b * 2048 + h * 512 + pn * 256) * 2048) * 2;
        u.nt = 4 * (pm + 1); u.pm = pm; u.pn = pn; u.z = bh; return true;
    }
};
struct SchedMoe {
    const char* A; const char* B; volatile LAS int* tab; int NT; size_t bexp; int G, c;
    __device__ __forceinline__ void ready(const Unit&, int) const {}
    __device__ __forceinline__ bool next(int i, Unit& u) const {
        const int NG = (G & 7) ? 1 : 8, x = c % NG, q = c / NG, W = G / NG, ne = 32 / NG;
        const int L = i * W + q; const int total = __builtin_amdgcn_readfirstlane(tab[ne]); if (L >= total) return false;
        int j = 0; while (L >= __builtin_amdgcn_readfirstlane(tab[j + 1])) ++j;
        const int e = x + NG * j, r = L - __builtin_amdgcn_readfirstlane(tab[j]), tiles = __builtin_amdgcn_readfirstlane(tab[40 + j]);
        const int ti = r % tiles, pn = r / tiles;
        u.a = A + ((size_t)e * CAP + (size_t)ti * 256) * 2048; u.b = B + (size_t)e * bexp + (size_t)pn * 256 * 2048; u.nt = 16; u.pm = ti; u.pn = pn; u.z = e; return true;
    }
};

struct SchedMoe2 {
    const char *Xs, *Ha, *Wgu, *Wd; volatile LAS int* tab; int G, c; unsigned* hcnt; unsigned* tmo; int kind;
    __device__ __forceinline__ bool next(int i, Unit& u) const {
        const int NG = (G & 7) ? 1 : 8, q = c / NG, W = G / NG, ne = 32 / NG;
        const int t10 = __builtin_amdgcn_readfirstlane(tab[ne]); const int n1 = (t10 > q) ? (t10 - q + W - 1) / W : 0;
        const int L = (kind == 0) ? i * W + q : (i + n1) * W + q; if (kind == 0 && L >= t10) return false;
        if (L < t10) { int j = 0; while (L >= __builtin_amdgcn_readfirstlane(tab[j + 1])) ++j;
            const int e = __builtin_amdgcn_readfirstlane(tab[(NG == 8 ? 48 : 80) + j]), r = L - __builtin_amdgcn_readfirstlane(tab[j]), tiles = __builtin_amdgcn_readfirstlane(tab[40 + j]); const int ti = r % tiles, pn = r / tiles;
            u.a = uniform_ptr(Xs + ((size_t)e * CAP + (size_t)ti * 256) * 2048); u.b = uniform_ptr(Wgu + (size_t)e * ((size_t)4096 * 2048) + (size_t)pn * 256 * 2048); u.nt = 16; u.pm = ti; u.pn = pn; u.z = e; return true; }
        const int L2 = L - t10; if (L2 >= (t10 >> 1)) return false;
        int j = 0; while (L2 >= (__builtin_amdgcn_readfirstlane(tab[j + 1]) >> 1)) ++j;
        const int e = __builtin_amdgcn_readfirstlane(tab[(NG == 8 ? 48 : 80) + j]), r = L2 - (__builtin_amdgcn_readfirstlane(tab[j]) >> 1), tiles = __builtin_amdgcn_readfirstlane(tab[40 + j]); const int ti = r % tiles, pn = r / tiles;
        u.a = uniform_ptr(Ha + ((size_t)e * CAP + (size_t)ti * 256) * 2048); u.b = uniform_ptr(Wd + (size_t)e * ((size_t)2048 * 2048) + (size_t)pn * 256 * 2048); u.nt = 16; u.pm = ti; u.pn = pn; u.z = e + 32; return true;
    }
    __device__ __forceinline__ void ready(const Unit& u, int wid) const {
        if (u.z < 32 || hcnt == nullptr) return;
        if (wid == 0) { unsigned* cp = hcnt + (size_t)((u.z - 32) * 32 + u.pm) * 16; unsigned spins = 0;
            while ((unsigned)__builtin_amdgcn_readfirstlane((int)__hip_atomic_load(cp, __ATOMIC_RELAXED, __HIP_MEMORY_SCOPE_AGENT)) < 128u) {
                if ((++spins & 63u) == 0u && __builtin_amdgcn_readfirstlane((int)__hip_atomic_load(tmo, __ATOMIC_RELAXED, __HIP_MEMORY_SCOPE_AGENT)) != 0) break;
                if (spins > (1u << 20)) { __hip_atomic_store(tmo, 1u, __ATOMIC_RELAXED, __HIP_MEMORY_SCOPE_AGENT); break; }
                __builtin_amdgcn_s_sleep(2); }
            __builtin_amdgcn_fence(__ATOMIC_ACQUIRE, "agent");
            asm volatile("s_waitcnt vmcnt(0)" ::: "memory"); }
        asm volatile("" ::: "memory"); __builtin_amdgcn_s_barrier(); asm volatile("" ::: "memory");
    }
};

using pg8::gelu_pk;
#define EPI_ARGS f32x4 (&acc)[2][2][4][2], const Unit& u, int wr, int wc, int fr, int fq
struct EpiIn {
    static constexpr bool PERM = true;
    const float* b_in; unsigned char* wsb;
    __device__ __forceinline__ bool operator()(EPI_ARGS) const {
        GAS unsigned char* w_ = (GAS unsigned char*)wsb; asm volatile("" : "+s"(w_));
        bf16* const Ug = (bf16*)(GAS bf16*)(w_ + WS_UG); bf16* const VgT = (bf16*)(GAS bf16*)(w_ + WS_VGT); bf16* const QKr = (bf16*)(GAS bf16*)(w_ + WS_QKR); bf16* const VmT = (bf16*)(GAS bf16*)(w_ + WS_VMT);
        bf16* const Og = (bf16*)(GAS bf16*)(w_ + WS_OG); bf16* const Ga = (bf16*)(GAS bf16*)(w_ + WS_GA); float* const vpart = (float*)(GAS float*)(w_ + WS_VPART);
        const int pn = u.pn; const int row0 = u.pm * 256 + wr * 64 + fr; const int cw = wc * 32 + 8 * fq;
        const int ncol0 = pn * 256 + cw; const int bcol0 = ncol0 + (ncol0 >= 12288 ? 8 : 0);
        f32x4 bv[2][2];
#pragma unroll
        for (int bj = 0; bj < 2; ++bj)
#pragma unroll
            for (int n = 0; n < 2; ++n) {
                const float* bp = b_in + bcol0 + bj * 128 + 4 * n; bv[bj][n] = (f32x4){bp[0], bp[1], bp[2], bp[3]}; }
        __builtin_amdgcn_s_waitcnt(0x0F70);
        if (pn < 8 || (pn >= 16 && pn < 32) || pn >= 40) {
            bf16* base; int ldc, colt; int act;
            if (pn < 8) { base = Ug; ldc = 2048; colt = pn * 256; act = 1; }
            else if (pn < 32) { base = QKr; ldc = 4096; colt = (pn - 16) * 256; act = 0; }
            else if (pn < 48) { base = Og; ldc = 2048; colt = (pn - 40) * 256; act = 2; }
            else { base = Ga; ldc = 2048; colt = (pn - 48) * 256; act = 2; if (pn >= 56) { base += (size_t)T * 2048; colt -= 2048; } }
#pragma unroll
            for (int ai = 0; ai < 2; ++ai)
#pragma unroll
                for (int m = 0; m < 4; ++m) { bf16* rowp = base + (size_t)(row0 + ai * 128 + m * 16) * ldc + colt + cw;
#pragma unroll
                    for (int bj = 0; bj < 2; ++bj) { f32x4 v0 = acc[ai][bj][m][0] + bv[bj][0], v1 = acc[ai][bj][m][1] + bv[bj][1];
                        if (act == 1) { f32x2 a = gelu_pk((f32x2){v0[0], v0[1]}), b = gelu_pk((f32x2){v0[2], v0[3]}), c = gelu_pk((f32x2){v1[0], v1[1]}), d = gelu_pk((f32x2){v1[2], v1[3]});
                            v0 = (f32x4){a.x, a.y, b.x, b.y}; v1 = (f32x4){c.x, c.y, d.x, d.y}; }
                        else if (act == 2) {
#pragma unroll
                            for (int j = 0; j < 4; ++j) { v0[j] = sigmoidf_(v0[j]); v1[j] = sigmoidf_(v1[j]); } }
                        u32x4 w; w.x = cvt_pk_bf16(v0[0], v0[1]); w.y = cvt_pk_bf16(v0[2], v0[3]); w.z = cvt_pk_bf16(v1[0], v1[1]); w.w = cvt_pk_bf16(v1[2], v1[3]);
                        *(u32x4*)(rowp + bj * 128) = w; } }
        } else {
            const bool isv = pn < 16; bf16* base = isv ? VgT : VmT; const int colt = (isv ? pn - 8 : pn - 32) * 256;
#pragma unroll
            for (int ai = 0; ai < 2; ++ai)
#pragma unroll
                for (int m = 0; m < 4; ++m) { const int row = row0 + ai * 128 + m * 16; const int b = row >> 11, s = row & 2047; float sm = 0.f, sq = 0.f;
#pragma unroll
                    for (int bj = 0; bj < 2; ++bj) { f32x4 v0 = acc[ai][bj][m][0] + bv[bj][0], v1 = acc[ai][bj][m][1] + bv[bj][1];
                        if (isv) { f32x2 a = gelu_pk((f32x2){v0[0], v0[1]}), bb = gelu_pk((f32x2){v0[2], v0[3]}), c = gelu_pk((f32x2){v1[0], v1[1]}), d = gelu_pk((f32x2){v1[2], v1[3]});
                            v0 = (f32x4){a.x, a.y, bb.x, bb.y}; v1 = (f32x4){c.x, c.y, d.x, d.y};
#pragma unroll
                            for (int j = 0; j < 4; ++j) { sm += v0[j] + v1[j]; sq += v0[j] * v0[j] + v1[j] * v1[j]; } }
                        bf16* cp = base + ((size_t)(b * 2048 + colt + bj * 128 + cw) * 2048 + s);
#pragma unroll
                        for (int j = 0; j < 4; ++j) { cp[(size_t)j * 2048] = (bf16)f2bf(v0[j]); cp[(size_t)(4 + j) * 2048] = (bf16)f2bf(v1[j]); } }
                    if (isv) { sm += __shfl_xor(sm, 16); sm += __shfl_xor(sm, 32); sq += __shfl_xor(sq, 16); sq += __shfl_xor(sq, 32);
                        if (fq == 0) { float* vp = vpart + (size_t)row * 64 + (pn - 8) * 4 + wc; vp[0] = sm; vp[32] = sq; } } }
        }
        return false;
    }
};
struct EpiSgu {
    static constexpr bool PERM = true;
    const bf16* Ug; const float* b_sgu; bf16* Y;
    __device__ __forceinline__ bool operator()(EPI_ARGS) const {
        const int g = u.pn; const int rt0 = wr * 64 + fr; const int cw = wc * 32 + 8 * fq;
#pragma unroll
        for (int ai = 0; ai < 2; ++ai) {
            u32x4 uu[4][2]; float bs[4];
#pragma unroll
            for (int m = 0; m < 4; ++m) { const int rt = rt0 + ai * 128 + m * 16; const size_t row = (size_t)u.pm * 256 + rt; bs[m] = b_sgu[g * 128 + (rt & 127)];
#pragma unroll
                for (int bj = 0; bj < 2; ++bj) uu[m][bj] = *(const u32x4*)(Ug + row * 2048 + g * 256 + bj * 128 + cw); }
#pragma unroll
            for (int m = 0; m < 4; ++m) { const int rt = rt0 + ai * 128 + m * 16; const size_t row = (size_t)u.pm * 256 + rt;
#pragma unroll
                for (int bj = 0; bj < 2; ++bj) { const int col = g * 256 + bj * 128 + cw; const u32x4 q = uu[m][bj];
                    const f32x4 v0 = acc[ai][bj][m][0] + bs[m], v1 = acc[ai][bj][m][1] + bs[m];
                    u32x4 w; w.x = cvt_pk_bf16(bflo(q.x) * v0[0], bfhi(q.x) * v0[1]); w.y = cvt_pk_bf16(bflo(q.y) * v0[2], bfhi(q.y) * v0[3]);
                    w.z = cvt_pk_bf16(bflo(q.z) * v1[0], bfhi(q.z) * v1[1]); w.w = cvt_pk_bf16(bflo(q.w) * v1[2], bfhi(q.w) * v1[3]);
                    *(u32x4*)(Y + row * 4096 + col) = w; } }
            asm volatile("" ::: "memory"); }
        return false;
    }
};
struct EpiQK {
    static constexpr bool PERM = true;
    const float *aS, *Mt; bf16* P; float* denp;
    __device__ __forceinline__ bool operator()(EPI_ARGS) const {
        const int bh = u.z; const int cw = wc * 32 + 8 * fq; const bool diag = (u.pm == u.pn);
        float av[2][8];
#pragma unroll
        for (int bj = 0; bj < 2; ++bj) { const float* ap = aS + bh * 2048 + u.pn * 256 + bj * 128 + cw;
#pragma unroll
            for (int j = 0; j < 8; ++j) av[bj][j] = ap[j] * 1.44269504089f; }
        const int rt0 = wr * 64 + fr;
        const float* mtp = Mt + bh * 2048 + u.pm * 256 + rt0; float* dpp = denp + (size_t)(bh * 2048 + u.pm * 256 + rt0) * 32 + u.pn * 4 + wc;
        bf16* prow = P + ((size_t)(bh * 2048 + u.pm * 256 + rt0) * 2048 + u.pn * 256 + cw);
        float mtv[8];
#pragma unroll
        for (int r8 = 0; r8 < 8; ++r8) mtv[r8] = mtp[(r8 >> 2) * 128 + (r8 & 3) * 16] * 1.44269504089f;
#pragma unroll
        for (int ai = 0; ai < 2; ++ai)
#pragma unroll
            for (int m = 0; m < 4; ++m) { const int ro = ai * 128 + m * 16; const float mt = mtv[ai * 4 + m]; float rs = 0.f;
#pragma unroll
                for (int bj = 0; bj < 2; ++bj) { float o[8];
                    const float lim = diag ? (float)(rt0 + ro - bj * 128 - cw + 1) : 1.0e9f;
#pragma unroll
                    for (int j = 0; j < 8; ++j) { const float sv = (j < 4) ? acc[ai][bj][m][0][j] : acc[ai][bj][m][1][j - 4];
                        const float w = __builtin_amdgcn_exp2f(fminf(av[bj][j] - mt, 0.f)); const float f = __builtin_amdgcn_fmed3f(lim - (float)j, 0.f, 1.f);
                        o[j] = sv * (w * f); rs += o[j]; }
                    u32x4 w4; w4.x = cvt_pk_bf16(o[0], o[1]); w4.y = cvt_pk_bf16(o[2], o[3]); w4.z = cvt_pk_bf16(o[4], o[5]); w4.w = cvt_pk_bf16(o[6], o[7]);
                    *(u32x4*)(prow + (size_t)ro * 2048 + bj * 128) = w4; }
                rs += __shfl_xor(rs, 16); rs += __shfl_xor(rs, 32);
                if (fq == 0) dpp[(size_t)ro * 32] = rs;
                asm volatile("" ::: "memory"); }
        return false;
    }
};
struct EpiPV {
    static constexpr bool PERM = true;
    const float *denp, *Bm; bf16* Hm; float* ssqp;
    __device__ __forceinline__ bool operator()(EPI_ARGS) const {
        const int bh = u.z, b = bh >> 2, h = bh & 3; const int cw = wc * 32 + 8 * fq; const int t0 = u.pm * 256 + wr * 64 + fr;
        float dsum[8], bm[8];
#pragma unroll
        for (int r8 = 0; r8 < 8; ++r8) { dsum[r8] = 0.f; bm[r8] = Bm[bh * 2048 + t0 + (r8 >> 2) * 128 + (r8 & 3) * 16]; }
        for (int q = 0; q <= u.pm; ++q) { f32x4 d4[8];
#pragma unroll
            for (int r8 = 0; r8 < 8; ++r8) d4[r8] = *(const f32x4*)(denp + (size_t)(bh * 2048 + t0 + (r8 >> 2) * 128 + (r8 & 3) * 16) * 32 + q * 4);
#pragma unroll
            for (int r8 = 0; r8 < 8; ++r8) dsum[r8] += (d4[r8].x + d4[r8].y) + (d4[r8].z + d4[r8].w); }
#pragma unroll
        for (int ai = 0; ai < 2; ++ai)
#pragma unroll
            for (int m = 0; m < 4; ++m) { const int t = t0 + ai * 128 + m * 16; const int tok = b * 2048 + t;
                const float dn = fabsf(dsum[ai * 4 + m]), lo = fast_exp(-bm[ai * 4 + m]); const float inv = 1.0f / fmaxf(dn, lo); float sq = 0.f;
#pragma unroll
                for (int bj = 0; bj < 2; ++bj) { const f32x4 v0 = acc[ai][bj][m][0] * inv, v1 = acc[ai][bj][m][1] * inv;
#pragma unroll
                    for (int j = 0; j < 4; ++j) sq += v0[j] * v0[j] + v1[j] * v1[j];
                    u32x4 w; w.x = cvt_pk_bf16(v0[0], v0[1]); w.y = cvt_pk_bf16(v0[2], v0[3]); w.z = cvt_pk_bf16(v1[0], v1[1]); w.w = cvt_pk_bf16(v1[2], v1[3]);
                    *(u32x4*)(Hm + (size_t)tok * 2048 + h * 512 + u.pn * 256 + bj * 128 + cw) = w; }
                sq += __shfl_xor(sq, 16); sq += __shfl_xor(sq, 32);
                if (fq == 0) ssqp[(size_t)(tok * 4 + h) * 8 + u.pn * 4 + wc] = sq; }
        return false;
    }
};
struct EpiMerge {
    static constexpr bool PERM = true;
    const bf16 *Ga, *Gm; bf16* Mrg;
    __device__ __forceinline__ bool operator()(EPI_ARGS) const {
        const int cw = wc * 32 + 8 * fq; const bool first = (u.z == 0);
#pragma unroll
        for (int ai = 0; ai < 2; ++ai) {
            u32x4 gmv[4][2], gav[4][2];
#pragma unroll
            for (int m = 0; m < 4; ++m) { const size_t row = (size_t)u.pm * 256 + wr * 64 + fr + ai * 128 + m * 16;
#pragma unroll
                for (int bj = 0; bj < 2; ++bj) { const size_t off = row * 2048 + u.pn * 256 + bj * 128 + cw;
                    gmv[m][bj] = *(const u32x4*)(Gm + off); if (first) gav[m][bj] = *(const u32x4*)(Ga + off); else gav[m][bj] = (u32x4){0u, 0u, 0u, 0u}; } }
#pragma unroll
            for (int m = 0; m < 4; ++m) { const size_t row = (size_t)u.pm * 256 + wr * 64 + fr + ai * 128 + m * 16;
#pragma unroll
                for (int bj = 0; bj < 2; ++bj) { const size_t off = row * 2048 + u.pn * 256 + bj * 128 + cw;
                    const u32x4 gm = gmv[m][bj];
                    float s[8] = {bflo(gm.x), bfhi(gm.x), bflo(gm.y), bfhi(gm.y), bflo(gm.z), bfhi(gm.z), bflo(gm.w), bfhi(gm.w)};
                    if (first) { const u32x4 ga = gav[m][bj];
                        const float a[8] = {bflo(ga.x), bfhi(ga.x), bflo(ga.y), bfhi(ga.y), bflo(ga.z), bfhi(ga.z), bflo(ga.w), bfhi(ga.w)};
#pragma unroll
                        for (int j = 0; j < 4; ++j) { acc[ai][bj][m][0][j] *= a[j] / fmaxf(s[j], 1e-30f); acc[ai][bj][m][1][j] *= a[4 + j] / fmaxf(s[4 + j], 1e-30f); }
                    } else { const f32x4 v0 = acc[ai][bj][m][0], v1 = acc[ai][bj][m][1];
                        u32x4 w; w.x = cvt_pk_bf16(v0[0] * s[0], v0[1] * s[1]); w.y = cvt_pk_bf16(v0[2] * s[2], v0[3] * s[3]); w.z = cvt_pk_bf16(v1[0] * s[4], v1[1] * s[5]); w.w = cvt_pk_bf16(v1[2] * s[6], v1[3] * s[7]);
                        *(u32x4*)(Mrg + off) = w; } } }
            asm volatile("" ::: "memory"); }
        return first;
    }
};
struct EpiX1 {
    static constexpr bool PERM = false;
    const float* x; float* x1;
    __device__ __forceinline__ bool operator()(EPI_ARGS) const {
        const int row0 = u.pm * 256 + wr * 64 + fr, col0 = u.pn * 256 + wc * 32 + 4 * fq;
#pragma unroll
        for (int ai = 0; ai < 2; ++ai)
#pragma unroll
            for (int m = 0; m < 4; ++m) { const size_t off = (size_t)(row0 + ai * 128 + m * 16) * 2048 + col0;
#pragma unroll
                for (int bj = 0; bj < 2; ++bj)
#pragma unroll
                    for (int n = 0; n < 2; ++n) { const f32x4 xv = *(const f32x4*)(x + off + bj * 128 + n * 16); *(f32x4*)(x1 + off + bj * 128 + n * 16) = xv + acc[ai][bj][m][n]; } }
        return false;
    }
};
struct EpiGU {
    static constexpr bool PERM = true;
    const float* b_gu; unsigned char* Ha;
    __device__ __forceinline__ bool operator()(EPI_ARGS) const {
        const int e = u.z & 31; const int cw = wc * 32 + 8 * fq; const float* bg = b_gu + (size_t)e * 4096 + u.pn * 128 + cw;
        float bgv[8], buv[8];
#pragma unroll
        for (int j = 0; j < 8; ++j) { bgv[j] = bg[j]; buv[j] = bg[2048 + j]; }
#pragma unroll
        for (int ai = 0; ai < 2; ++ai)
#pragma unroll
            for (int m = 0; m < 4; ++m) { const size_t row = (size_t)e * CAP + (size_t)u.pm * 256 + wr * 64 + fr + ai * 128 + m * 16; float o[8];
#pragma unroll
                for (int j = 0; j < 8; ++j) { float gt = ((j < 4) ? acc[ai][0][m][0][j] : acc[ai][0][m][1][j - 4]) + bgv[j]; float up = ((j < 4) ? acc[ai][1][m][0][j] : acc[ai][1][m][1][j - 4]) + buv[j];
                    gt = fminf(gt, 7.0f); up = fminf(fmaxf(up, -7.0f), 7.0f);
                    o[j] = (up + 1.0f) * (gt * sigmoidf_(1.702f * gt)); }
                u32x2 w; w.x = pk4_fp8(o[0], o[1], o[2], o[3]); w.y = pk4_fp8(o[4], o[5], o[6], o[7]);
                *(u32x2*)(Ha + row * 2048 + u.pn * 128 + cw) = w; }
        return false;
    }
};
struct EpiDown {
    static constexpr bool PERM = true;
    const float* b_d; bf16* Ye;
    __device__ __forceinline__ bool operator()(EPI_ARGS) const {
        const int e = u.z & 31; const int cw = wc * 32 + 8 * fq;
        f32x4 bv[2][2];
#pragma unroll
        for (int bj = 0; bj < 2; ++bj)
#pragma unroll
            for (int n = 0; n < 2; ++n) bv[bj][n] = *(const f32x4*)(b_d + (size_t)e * 2048 + u.pn * 256 + bj * 128 + cw + 4 * n);
#pragma unroll
        for (int ai = 0; ai < 2; ++ai)
#pragma unroll
            for (int m = 0; m < 4; ++m) { const size_t row = (size_t)e * CAP + (size_t)u.pm * 256 + wr * 64 + fr + ai * 128 + m * 16;
#pragma unroll
                for (int bj = 0; bj < 2; ++bj) { const f32x4 v0 = acc[ai][bj][m][0] + bv[bj][0], v1 = acc[ai][bj][m][1] + bv[bj][1];
                    u32x4 w; w.x = cvt_pk_bf16(v0[0], v0[1]); w.y = cvt_pk_bf16(v0[2], v0[3]); w.z = cvt_pk_bf16(v1[0], v1[1]); w.w = cvt_pk_bf16(v1[2], v1[3]);
                    *(u32x4*)(Ye + row * 2048 + u.pn * 256 + bj * 128 + cw) = w; } }
        return false;
    }
};

struct EpiGUc {
    static constexpr bool PERM = true;
    const float* b_gu; unsigned char* Ha; unsigned* hcnt; mutable int pend;
    __device__ __forceinline__ void flush(int lane) const { if (pend >= 0 && lane == 0) __hip_atomic_fetch_add(hcnt + (size_t)pend * 16, 1u, __ATOMIC_RELAXED, __HIP_MEMORY_SCOPE_AGENT); pend = -1; }
    __device__ __forceinline__ bool operator()(EPI_ARGS) const {
        flush(fr + 16 * fq);
        const int e = u.z & 31; const int cw = wc * 32 + 8 * fq;
        const float* bg = b_gu + (size_t)e * 4096 + u.pn * 128 + cw; const f32x4 g0 = *(const f32x4*)bg, g1 = *(const f32x4*)(bg + 4), u0 = *(const f32x4*)(bg + 2048), u1 = *(const f32x4*)(bg + 2052);
        const float bgv[8] = {g0.x, g0.y, g0.z, g0.w, g1.x, g1.y, g1.z, g1.w}, buv[8] = {u0.x, u0.y, u0.z, u0.w, u1.x, u1.y, u1.z, u1.w};
#pragma unroll
        for (int ai = 0; ai < 2; ++ai)
#pragma unroll
            for (int m = 0; m < 4; ++m) { const size_t row = (size_t)e * CAP + (size_t)u.pm * 256 + wr * 64 + fr + ai * 128 + m * 16; float o[8];
#pragma unroll
                for (int j = 0; j < 8; ++j) { float gt = ((j < 4) ? acc[ai][0][m][0][j] : acc[ai][0][m][1][j - 4]) + bgv[j]; float up = ((j < 4) ? acc[ai][1][m][0][j] : acc[ai][1][m][1][j - 4]) + buv[j];
                    gt = fminf(gt, 7.0f); up = fminf(fmaxf(up, -7.0f), 7.0f);
                    o[j] = (up + 1.0f) * (gt * sigmoidf_(1.702f * gt)); }
                const unsigned long long w = (unsigned long long)pk4_fp8(o[0], o[1], o[2], o[3]) | ((unsigned long long)pk4_fp8(o[4], o[5], o[6], o[7]) << 32);
                __hip_atomic_store((unsigned long long*)(Ha + row * 2048 + u.pn * 128 + cw), w, __ATOMIC_RELAXED, __HIP_MEMORY_SCOPE_AGENT); }
        pend = e * 32 + u.pm;
        return false;
    }
};

struct Args { const float* in[22]; float* out; unsigned char* ws; int ph_lo, ph_hi, li, pad; };
struct Frame {
    LAS unsigned char* lds; int wave, G, bx;
    unsigned char* ws;
};
template <int OFF> __device__ __forceinline__ unsigned long long karg_u64() {
    auto kp = __builtin_amdgcn_kernarg_segment_ptr();
    unsigned long long v;
    asm volatile("s_load_dwordx2 %0, %1, %2\n\ts_waitcnt lgkmcnt(0)" : "=s"(v) : "s"(kp), "i"(OFF));
    return v;
}
#define INP(i) ((const float*)(const GAS float*)karg_u64<8 * (i)>())
#define OUTP() ((float*)(GAS float*)karg_u64<176>())
#define WSP() ((unsigned char*)(GAS unsigned char*)karg_u64<184>())

__device__ __forceinline__ void transpose_item(const float* src, size_t spitch, int k0, int n0, bf16* dst, size_t dpitch, int drow0, int dk0, LAS float* scr, int lane) {
#pragma unroll 8
    for (int i = 0; i < 32; ++i) { const int kk = 2 * i + (lane >> 5); scr[kk * 33 + (lane & 31)] = src[(size_t)(k0 + kk) * spitch + n0 + (lane & 31)]; }
    LDS_WAIT(); asm volatile("" ::: "memory");
    const int c = lane & 7;
#pragma unroll
    for (int j = 0; j < 4; ++j) { const int n = (lane >> 3) + 8 * j; const LAS float* s = scr + (8 * c) * 33 + n;
        u32x4 o; o.x = pk2(s[0 * 33], s[1 * 33]); o.y = pk2(s[2 * 33], s[3 * 33]); o.z = pk2(s[4 * 33], s[5 * 33]); o.w = pk2(s[6 * 33], s[7 * 33]);
        *(u32x4*)(dst + (size_t)(drow0 + n) * dpitch + dk0 + 8 * c) = o; }
    LDS_WAIT(); asm volatile("" ::: "memory");
}

__device__ __forceinline__ void transpose_item_fp8(const float* src, size_t spitch, int k0, int n0, unsigned char* dst, size_t dpitch, int drow0, int dk0, LAS float* scr, int lane) {
#pragma unroll 8
    for (int i = 0; i < 32; ++i) { const int kk = 2 * i + (lane >> 5); scr[kk * 33 + (lane & 31)] = src[(size_t)(k0 + kk) * spitch + n0 + (lane & 31)]; }
    LDS_WAIT(); asm volatile("" ::: "memory");
    const int c = lane & 3;
#pragma unroll
    for (int j = 0; j < 2; ++j) { const int n = (lane >> 2) + 16 * j; const LAS float* s = scr + (16 * c) * 33 + n;
        u32x4 o; o.x = pk4_fp8(s[0 * 33] * 64.f, s[1 * 33] * 64.f, s[2 * 33] * 64.f, s[3 * 33] * 64.f); o.y = pk4_fp8(s[4 * 33] * 64.f, s[5 * 33] * 64.f, s[6 * 33] * 64.f, s[7 * 33] * 64.f);
        o.z = pk4_fp8(s[8 * 33] * 64.f, s[9 * 33] * 64.f, s[10 * 33] * 64.f, s[11 * 33] * 64.f); o.w = pk4_fp8(s[12 * 33] * 64.f, s[13 * 33] * 64.f, s[14 * 33] * 64.f, s[15 * 33] * 64.f);
        *(u32x4*)(dst + (size_t)(drow0 + n) * dpitch + dk0 + 16 * c) = o; }
    LDS_WAIT(); asm volatile("" ::: "memory");
}

__device__ __forceinline__ void conv_item_bf16(const float* src, size_t spitch, int k0, int n0, bf16* dst, size_t dpitch, int drow0, int dk0, int lane) {
    const int kg = lane >> 3, ng = lane & 7; const float* s = src + (size_t)(k0 + kg * 16) * spitch + n0 + 4 * ng; f32x4 v[16];
#pragma unroll
    for (int i = 0; i < 16; ++i) v[i] = __builtin_nontemporal_load((const f32x4*)(s + (size_t)i * spitch));
    bf16* d = dst + (size_t)(drow0 + 4 * ng) * dpitch + dk0 + kg * 16;
#pragma unroll
    for (int c = 0; c < 4; ++c) { u32x4 o0, o1;
        o0.x = pk2(v[0][c], v[1][c]); o0.y = pk2(v[2][c], v[3][c]); o0.z = pk2(v[4][c], v[5][c]); o0.w = pk2(v[6][c], v[7][c]);
        o1.x = pk2(v[8][c], v[9][c]); o1.y = pk2(v[10][c], v[11][c]); o1.z = pk2(v[12][c], v[13][c]); o1.w = pk2(v[14][c], v[15][c]);
        *(u32x4*)(d + (size_t)c * dpitch) = o0; *(u32x4*)(d + (size_t)c * dpitch + 8) = o1; }
}

__device__ __forceinline__ void conv_item_fp8(const float* src, size_t spitch, int k0, int n0, unsigned char* dst, size_t dpitch, int drow0, int dk0, int lane) {
    const int kg = lane >> 3, ng = lane & 7; const float* s = src + (size_t)(k0 + kg * 16) * spitch + n0 + 4 * ng; f32x4 v[16];
#pragma unroll
    for (int i = 0; i < 16; ++i) v[i] = __builtin_nontemporal_load((const f32x4*)(s + (size_t)i * spitch));
    unsigned char* d = dst + (size_t)(drow0 + 4 * ng) * dpitch + dk0 + kg * 16;
#pragma unroll
    for (int c = 0; c < 4; ++c) { u32x4 o;
        o.x = pk4_fp8(v[0][c] * 64.f, v[1][c] * 64.f, v[2][c] * 64.f, v[3][c] * 64.f); o.y = pk4_fp8(v[4][c] * 64.f, v[5][c] * 64.f, v[6][c] * 64.f, v[7][c] * 64.f);
        o.z = pk4_fp8(v[8][c] * 64.f, v[9][c] * 64.f, v[10][c] * 64.f, v[11][c] * 64.f); o.w = pk4_fp8(v[12][c] * 64.f, v[13][c] * 64.f, v[14][c] * 64.f, v[15][c] * 64.f);
        *(u32x4*)(d + (size_t)c * dpitch) = o; }
}

__device__ __forceinline__ void conv_load(const float* src, size_t spitch, int k0, int n0, int lane, f32x4 (&v)[16]) {
    const int kg = lane >> 3, ng = lane & 7; const float* s = src + (size_t)(k0 + kg * 16) * spitch + n0 + 4 * ng;
#pragma unroll
    for (int i = 0; i < 16; ++i) v[i] = __builtin_nontemporal_load((const f32x4*)(s + (size_t)i * spitch));
}
__device__ __forceinline__ void conv_store_bf16(const f32x4 (&v)[16], bf16* dst, size_t dpitch, int drow0, int dk0, int lane) {
    const int kg = lane >> 3, ng = lane & 7; bf16* d = dst + (size_t)(drow0 + 4 * ng) * dpitch + dk0 + kg * 16;
#pragma unroll
    for (int c = 0; c < 4; ++c) { u32x4 o0, o1;
        o0.x = pk2(v[0][c], v[1][c]); o0.y = pk2(v[2][c], v[3][c]); o0.z = pk2(v[4][c], v[5][c]); o0.w = pk2(v[6][c], v[7][c]);
        o1.x = pk2(v[8][c], v[9][c]); o1.y = pk2(v[10][c], v[11][c]); o1.z = pk2(v[12][c], v[13][c]); o1.w = pk2(v[14][c], v[15][c]);
        *(u32x4*)(d + (size_t)c * dpitch) = o0; *(u32x4*)(d + (size_t)c * dpitch + 8) = o1; }
}
__device__ __forceinline__ void conv_store_fp8(const f32x4 (&v)[16], unsigned char* dst, size_t dpitch, int drow0, int dk0, int lane) {
    const int kg = lane >> 3, ng = lane & 7; unsigned char* d = dst + (size_t)(drow0 + 4 * ng) * dpitch + dk0 + kg * 16;
#pragma unroll
    for (int c = 0; c < 4; ++c) { u32x4 o;
        o.x = pk4_fp8(v[0][c] * 64.f, v[1][c] * 64.f, v[2][c] * 64.f, v[3][c] * 64.f); o.y = pk4_fp8(v[4][c] * 64.f, v[5][c] * 64.f, v[6][c] * 64.f, v[7][c] * 64.f);
        o.z = pk4_fp8(v[8][c] * 64.f, v[9][c] * 64.f, v[10][c] * 64.f, v[11][c] * 64.f); o.w = pk4_fp8(v[12][c] * 64.f, v[13][c] * 64.f, v[14][c] * 64.f, v[15][c] * 64.f);
        *(u32x4*)(d + (size_t)c * dpitch) = o; }
}

struct ConvPoolB {
    const float *pa, *pm, *wo; bf16 *pam, *wout; int first, n;
    __device__ __forceinline__ void run(int, int lane) const {
        for (int jj = 0; jj < n; ++jj) { int r = first + jj;
            if (r < 1024) { const int kb = r >> 6, nb = r & 63; conv_item_bf16(pa, 2048, kb * 128, nb * 32, pam, 4096, nb * 32, kb * 128, lane); continue; } r -= 1024;
            if (r < 1024) { const int kb = r >> 6, nb = r & 63; conv_item_bf16(pm, 2048, kb * 128, nb * 32, pam, 4096, nb * 32, 2048 + kb * 128, lane); continue; } r -= 1024;
            { const int kb = r >> 6, nb = r & 63; conv_item_bf16(wo, 2048, kb * 128, nb * 32, wout, 2048, nb * 32, kb * 128, lane); } }
    }
};

__device__ __forceinline__ void p0_prologue(Frame& F) {
    const int lane = lane_id(), tid = F.wave * 64 + lane; (void)tid;
    LAS float* scr = (LAS float*)(F.lds + F.wave * 16384);
    const int gw = F.bx * NWAVES + F.wave, NGW = F.G * NWAVES;
    const float* Win = INP(2);
    constexpr int I_IN = 16 * 512, I_P = 16 * 64;
    const int NITEMS = I_IN + (F.G == 256 ? 0 : 3 * I_P);
    for (int it = gw; it < I_IN; it += 2 * NGW) { f32x4 va[16], vb[16]; const int it2 = it + NGW; const bool two = it2 < I_IN;
        { const int kb = it >> 9, n0 = (it & 511) * 32; conv_load(Win, INC, kb * 128, n0 < 12288 ? n0 : n0 + 8, lane, va); }
        if (two) { const int kb = it2 >> 9, n0 = (it2 & 511) * 32; conv_load(Win, INC, kb * 128, n0 < 12288 ? n0 : n0 + 8, lane, vb); }
        { const int kb = it >> 9, n0 = (it & 511) * 32;
          if (n0 < N_BF16_TILES * 256) conv_store_bf16(va, (bf16*)(F.ws + WS_WIN), 2048, n0, kb * 128, lane); else conv_store_fp8(va, (unsigned char*)(F.ws + WS_WIN8), 2048, n0 - N_BF16_TILES * 256, kb * 128, lane); }
        if (two) { const int kb = it2 >> 9, n0 = (it2 & 511) * 32;
          if (n0 < N_BF16_TILES * 256) conv_store_bf16(vb, (bf16*)(F.ws + WS_WIN), 2048, n0, kb * 128, lane); else conv_store_fp8(vb, (unsigned char*)(F.ws + WS_WIN8), 2048, n0 - N_BF16_TILES * 256, kb * 128, lane); }
    }
    for (int it = I_IN + gw; it < NITEMS; it += NGW) {
        int r = it - I_IN;
        if (r < I_P) { const int kb = r >> 6, nb = r & 63; conv_item_bf16(INP(11), 2048, kb * 128, nb * 32, (bf16*)(F.ws + WS_PAM), 4096, nb * 32, kb * 128, lane); continue; } r -= I_P;
        if (r < I_P) { const int kb = r >> 6, nb = r & 63; conv_item_bf16(INP(12), 2048, kb * 128, nb * 32, (bf16*)(F.ws + WS_PAM), 4096, nb * 32, 2048 + kb * 128, lane); continue; } r -= I_P;
        { const int kb = r >> 6, nb = r & 63; conv_item_bf16(INP(13), 2048, kb * 128, nb * 32, (bf16*)(F.ws + WS_WOUT), 2048, nb * 32, kb * 128, lane); }
    }
    { bf16* Wbd = (bf16*)(F.ws + WS_WBD); const float* wsgu = INP(6);
      for (int i = F.bx * NTHR + tid; i < 8 * 256 * 256; i += F.G * NTHR) { const int g = i >> 16, t = (i >> 8) & 255, s = i & 255; float v = 0.f;
          if ((t >> 7) == (s >> 7)) { const int tt = t & 127, ss = s & 127; if ((ss >> 6) <= (tt >> 6)) v = wsgu[(g * 128 + tt) * 128 + ss]; }
          Wbd[i] = (bf16)f2bf(v); } }
    __syncthreads();
    LAS float* wg = (LAS float*)F.lds;
    for (int i = tid; i < 2048 * 8; i += NTHR) { const int ch = i >> 3, q = i & 7; wg[(((((ch >> 8) * 4 + (ch & 3)) * 2 + (q >> 2)) * 64 + ((ch >> 2) & 63)) << 2) + (q & 3)] = Win[(size_t)ch * INC + 12288 + q]; }
    __syncthreads();
    const float* x = INP(0); const float* gmix = INP(1); const float* b_in = INP(3);
    bf16* H = (bf16*)(F.ws + WS_H); float* G8 = (float*)(F.ws + WS_G8);
    f32x4 gv[8], xn[8];
#pragma unroll
    for (int j = 0; j < 8; ++j) gv[j] = ((const f32x4*)gmix)[64 * j + lane];
    if (gw < T) {
#pragma unroll
        for (int j = 0; j < 8; ++j) xn[j] = ((const f32x4*)(x + (size_t)gw * D) + lane)[64 * j]; }
    for (int mrow = gw; mrow < T; mrow += NGW) {
        f32x4 xv[8]; float s = 0.f;
#pragma unroll
        for (int j = 0; j < 8; ++j) { xv[j] = xn[j]; s += (xv[j].x * xv[j].x + xv[j].y * xv[j].y) + (xv[j].z * xv[j].z + xv[j].w * xv[j].w); }
        if (mrow + NGW < T) {
#pragma unroll
            for (int j = 0; j < 8; ++j) xn[j] = ((const f32x4*)(x + (size_t)(mrow + NGW) * D) + lane)[64 * j]; }
        const float rstd = 1.0f / sqrtf(wave_sum(s) * (1.0f / D) + EPS);
        float ga[8];
#pragma unroll
        for (int q = 0; q < 8; ++q) ga[q] = 0.f;
        unsigned long long* o8 = (unsigned long long*)(H + (size_t)mrow * D) + lane;
#pragma unroll
        for (int j = 0; j < 8; ++j) { const f32x4 hv = xv[j] * rstd * gv[j];
            o8[64 * j] = (unsigned long long)pk2(hv.x, hv.y) | ((unsigned long long)pk2(hv.z, hv.w) << 32);
            ((unsigned*)((unsigned char*)(F.ws + WS_H8) + (size_t)mrow * D))[64 * j + lane] = pk4_fp8(hv.x, hv.y, hv.z, hv.w);
            const LAS float* wp = wg + j * 2048 + lane * 4;
#pragma unroll
            for (int i = 0; i < 4; ++i) { const f32x4 w0 = *(const LAS f32x4*)(wp + i * 512), w1 = *(const LAS f32x4*)(wp + i * 512 + 256);
                ga[0] += hv[i] * w0.x; ga[1] += hv[i] * w0.y; ga[2] += hv[i] * w0.z; ga[3] += hv[i] * w0.w; ga[4] += hv[i] * w1.x; ga[5] += hv[i] * w1.y; ga[6] += hv[i] * w1.z; ga[7] += hv[i] * w1.w; }
            asm volatile("" ::: "memory"); }
#pragma unroll
        for (int q = 0; q < 8; ++q) ga[q] = wave_sum(ga[q]);
        if (lane < 8) { float val = ga[0];
#pragma unroll
            for (int q = 1; q < 8; ++q) val = (lane == q) ? ga[q] : val;
            G8[(size_t)mrow * 8 + lane] = val + b_in[12288 + lane]; }
    }
    __syncthreads();
}

__device__ __forceinline__ void p2_elementwise(Frame& F) {
    const int lane = lane_id(), tid = F.wave * 64 + lane; (void)tid;
    if (F.bx < 16 && F.wave == 0) {
        const int bh = F.bx, b = bh >> 2, h = bh & 3; const float* gp = (const float*)(F.ws + WS_G8) + ((size_t)b * 2048 + lane * 32) * 8;
        float* aS = (float*)(F.ws + WS_AS) + bh * 2048 + lane * 32; float* Mt = (float*)(F.ws + WS_MT) + bh * 2048 + lane * 32; float* Bm = (float*)(F.ws + WS_BM) + bh * 2048 + lane * 32;
        float lf[32], av[32];
#pragma unroll
        for (int c = 0; c < 32; ++c) { const float fg = gp[c * 8 + 4 + h]; av[c] = gp[c * 8 + h]; lf[c] = fminf(fg, 0.f) - log1pf(expf(-fabsf(fg))); }
        double tot = 0.0;
#pragma unroll
        for (int c = 0; c < 32; ++c) tot += (double)lf[c];
#pragma unroll
        for (int o = 1; o < 64; o <<= 1) { const double t = __shfl_up(tot, o); if (lane >= o) tot += t; }
        double excl = __shfl_up(tot, 1); if (lane == 0) excl = 0.0;
        double run = excl; float lm = -3.0e38f;
#pragma unroll
        for (int c = 0; c < 32; ++c) { run += (double)lf[c]; av[c] -= (float)run; lm = fmaxf(lm, av[c]); }
#pragma unroll
        for (int o = 1; o < 64; o <<= 1) { const float t = __shfl_up(lm, o); if (lane >= o) lm = fmaxf(lm, t); }
        float mx = __shfl_up(lm, 1); if (lane == 0) mx = 0.f; mx = fmaxf(mx, 0.f);
        run = excl;
#pragma unroll
        for (int c4 = 0; c4 < 8; ++c4) { f32x4 a4, m4, b4;
#pragma unroll
            for (int j = 0; j < 4; ++j) { const int c = c4 * 4 + j; run += (double)lf[c]; mx = fmaxf(mx, av[c]); a4[j] = av[c]; m4[j] = mx; b4[j] = (float)(run + (double)mx); }
            *(f32x4*)(aS + c4 * 4) = a4; *(f32x4*)(Mt + c4 * 4) = m4; *(f32x4*)(Bm + c4 * 4) = b4; }
    }
    const int gt = F.bx * NTHR + tid, NT_ = F.G * NTHR;
    { const bf16* QKr = (const bf16*)(F.ws + WS_QKR); bf16* QKc = (bf16*)(F.ws + WS_QKC); const float* wc = INP(4); const float* bc = INP(5);
      const int c0 = (gt & 511) * 8; const float sc = (c0 < 2048) ? 0.04419417382f : 1.0f;
      f32x4 w[4][2];
#pragma unroll
      for (int k = 0; k < 4; ++k) { w[k][0] = *(const f32x4*)(wc + k * 4096 + c0); w[k][1] = *(const f32x4*)(wc + k * 4096 + c0 + 4); }
      const f32x4 b0 = *(const f32x4*)(bc + c0), b1 = *(const f32x4*)(bc + c0 + 4);
      for (int it = gt; it < (T / 4) * 512; it += 2 * NT_) { u32x4 z[2][7]; int tk[2];
#pragma unroll
          for (int q = 0; q < 2; ++q) { const int itq = it + q * NT_; const bool ok = itq < (T / 4) * 512; const int tok = ok ? (itq >> 9) * 4 : 0; tk[q] = ok ? tok : -1; const int s = tok & 2047;
#pragma unroll
              for (int r = 0; r < 7; ++r) { z[q][r] = (u32x4){0u, 0u, 0u, 0u}; if (r >= 3 || s > 0) z[q][r] = *(const u32x4*)(QKr + (size_t)(tok - 3 + r) * 4096 + c0); } }
#pragma unroll
          for (int q = 0; q < 2; ++q) { if (tk[q] < 0) continue;
#pragma unroll
              for (int o = 0; o < 4; ++o) { f32x4 a0 = b0, a1 = b1;
#pragma unroll
                  for (int k = 0; k < 4; ++k) { const u32x4 zz = z[q][o + k];
                      a0.x += bflo(zz.x) * w[k][0].x; a0.y += bfhi(zz.x) * w[k][0].y; a0.z += bflo(zz.y) * w[k][0].z; a0.w += bfhi(zz.y) * w[k][0].w;
                      a1.x += bflo(zz.z) * w[k][1].x; a1.y += bfhi(zz.z) * w[k][1].y; a1.z += bflo(zz.w) * w[k][1].z; a1.w += bfhi(zz.w) * w[k][1].w; }
#pragma unroll
                  for (int j = 0; j < 4; ++j) { a0[j] = a0[j] * sigmoidf_(a0[j]) * sc; a1[j] = a1[j] * sigmoidf_(a1[j]) * sc; }
                  u32x4 ov; ov.x = pk2(a0.x, a0.y); ov.y = pk2(a0.z, a0.w); ov.z = pk2(a1.x, a1.y); ov.w = pk2(a1.z, a1.w);
                  *(u32x4*)(QKc + (size_t)(tk[q] + o) * 4096 + c0) = ov; } } } }
    { bf16* VgT = (bf16*)(F.ws + WS_VGT); const float* vpart = (const float*)(F.ws + WS_VPART); const float* gln = INP(8); const float* bln = INP(9);
      LAS float* st = (LAS float*)(F.lds + MISC_OFF + 64);
      for (int bi = F.bx; bi < T / 32; bi += F.G) {
          const int xq = bi & 7, qq = (bi >> 3) & 31, hi_ = bi >> 8; const int blk = hi_ * 256 + 2 * (8 * (qq >> 1) + xq) + (qq & 1);
          const int tok0 = blk * 32, b = tok0 >> 11, s0 = tok0 & 2047;
          __syncthreads();
          if (tid < 32) { const f32x4* vp = (const f32x4*)(vpart + (size_t)(tok0 + tid) * 64); float sm = 0.f, sq = 0.f;
#pragma unroll
              for (int q = 0; q < 8; ++q) { const f32x4 a = vp[q], c = vp[8 + q]; sm += (a.x + a.y) + (a.z + a.w); sq += (c.x + c.y) + (c.z + c.w); }
              const float mu = sm * (1.0f / 2048.0f); const float var = fmaxf(sq * (1.0f / 2048.0f) - mu * mu, 0.f); st[tid] = mu; st[32 + tid] = 1.0f / sqrtf(var + EPS); }
          __syncthreads();
          u32x4 zv[16];
#pragma unroll
          for (int k = 0; k < 16; ++k) { const int i = tid + k * NTHR; const int d = i >> 2, grp = i & 3; zv[k] = *(const u32x4*)(VgT + ((size_t)(b * 2048 + d) * 2048 + s0 + grp * 8)); }
#pragma unroll
          for (int k = 0; k < 16; ++k) { const int i = tid + k * NTHR; const int d = i >> 2, grp = i & 3; bf16* p = VgT + ((size_t)(b * 2048 + d) * 2048 + s0 + grp * 8);
              const u32x4 z = zv[k]; const float gg = gln[d], bb = bln[d];
              float v[8] = {bflo(z.x), bfhi(z.x), bflo(z.y), bfhi(z.y), bflo(z.z), bfhi(z.z), bflo(z.w), bfhi(z.w)};
#pragma unroll
              for (int j = 0; j < 8; ++j) v[j] = (v[j] - st[grp * 8 + j]) * st[32 + grp * 8 + j] * gg + bb;
              u32x4 o; o.x = pk2(v[0], v[1]); o.y = pk2(v[2], v[3]); o.z = pk2(v[4], v[5]); o.w = pk2(v[6], v[7]);
              *(u32x4*)p = o; } }
      __syncthreads(); }
}

__device__ __forceinline__ void p5_ym(Frame& F) {
    const int lane = lane_id(), tid = F.wave * 64 + lane; (void)tid;
    const int gt = F.bx * NTHR + tid, NT_ = F.G * NTHR;
    const bf16* Hm = (const bf16*)(F.ws + WS_HM); const bf16* Og = (const bf16*)(F.ws + WS_OG); const float* ssqp = (const float*)(F.ws + WS_SSQP); const float* gn = INP(10);
    bf16* Y = (bf16*)(F.ws + WS_Y);
    const int c0 = (gt & 255) * 8, h = c0 >> 9; const f32x4 g0 = *(const f32x4*)(gn + c0), g1 = *(const f32x4*)(gn + c0 + 4);
    for (int it = gt; it < T * 256; it += 4 * NT_) { f32x4 q0[4], q1[4]; u32x4 hv[4], ov[4];
#pragma unroll
        for (int k = 0; k < 4; ++k) { const int itk = it + k * NT_; const int tok = (itk < T * 256) ? (itk >> 8) : 0;
            q0[k] = *(const f32x4*)(ssqp + (size_t)(tok * 4 + h) * 8); q1[k] = *(const f32x4*)(ssqp + (size_t)(tok * 4 + h) * 8 + 4);
            hv[k] = *(const u32x4*)(Hm + (size_t)tok * 2048 + c0); ov[k] = *(const u32x4*)(Og + (size_t)tok * 2048 + c0); }
#pragma unroll
        for (int k = 0; k < 4; ++k) { const int itk = it + k * NT_; if (itk >= T * 256) continue; const int tok = itk >> 8;
            const float rstd = 1.0f / sqrtf((((q0[k].x + q0[k].y) + (q0[k].z + q0[k].w)) + ((q1[k].x + q1[k].y) + (q1[k].z + q1[k].w))) * (1.0f / 512.0f) + EPS);
            u32x4 o; o.x = pk2(bflo(hv[k].x) * rstd * g0.x * bflo(ov[k].x), bfhi(hv[k].x) * rstd * g0.y * bfhi(ov[k].x)); o.y = pk2(bflo(hv[k].y) * rstd * g0.z * bflo(ov[k].y), bfhi(hv[k].y) * rstd * g0.w * bfhi(ov[k].y));
            o.z = pk2(bflo(hv[k].z) * rstd * g1.x * bflo(ov[k].z), bfhi(hv[k].z) * rstd * g1.y * bfhi(ov[k].z)); o.w = pk2(bflo(hv[k].w) * rstd * g1.z * bflo(ov[k].w), bfhi(hv[k].w) * rstd * g1.w * bfhi(ov[k].w));
            *(u32x4*)(Y + (size_t)tok * 4096 + 2048 + c0) = o; } }
}

__device__ __forceinline__ void p8_router(Frame& F) {
    const int lane = lane_id(), tid = F.wave * 64 + lane; (void)tid;
    const float* x1 = (const float*)(F.ws + WS_X1); const float* gmoe = INP(14); const float* Wr = INP(15); const float* br = INP(16);
    LAS float* hT = (LAS float*)F.lds;
    LAS float* WrL = (LAS float*)(F.lds + 65536);
    LAS float* red = (LAS float*)(F.lds + 81920);
    LAS float* misc = (LAS float*)(F.lds + MISC_OFF + 64);
    LAS float* rstd_s = misc; LAS int* sel_e = (LAS int*)(misc + 32); LAS float* sel_g = misc + 32 + 128; LAS int* sel_pos = (LAS int*)(misc + 32 + 256);
    LAS int* lcnt = (LAS int*)(misc + 32 + 384); LAS int* lbase = lcnt + 32;
    if (tid < 32) lcnt[tid] = 0;
    int* ecnt = (int*)(F.ws + CTLB_ECNT); int* slot = (int*)(F.ws + WS_SLOT); float* slotg = (float*)(F.ws + WS_SLOT + 128 * 1024);
    unsigned char* Xs = (unsigned char*)(F.ws + WS_XS);
    for (int tb = F.bx; tb < T / 32; tb += F.G) {
        const int tok0 = tb * 32;
        float accr[16];
#pragma unroll
        for (int q = 0; q < 16; ++q) accr[q] = 0.f;
        float ssl[4] = {0.f, 0.f, 0.f, 0.f};
        float xv[8][4], gq[8]; f32x4 wv[8];
#define ROUTER_ISSUE(qq) do { _Pragma("unroll") for (int i = 0; i < 8; ++i) { const int c = 64 * i + lane; gq[i] = gmoe[(qq) * 512 + c]; \
            _Pragma("unroll") for (int r = 0; r < 4; ++r) xv[i][r] = x1[(size_t)(tok0 + F.wave * 4 + r) * D + (qq) * 512 + c]; \
            wv[i] = ((const f32x4*)(Wr + (size_t)(qq) * 512 * 32))[i * NTHR + tid]; } } while (0)
        ROUTER_ISSUE(0);
#pragma unroll 1
        for (int qt = 0; qt < 4; ++qt) {
            __syncthreads();
#pragma unroll
            for (int i = 0; i < 8; ++i) { const int c = 64 * i + lane; f32x4 hv;
#pragma unroll
                for (int r = 0; r < 4; ++r) { const float v = xv[i][r]; ssl[r] += v * v; hv[r] = v * gq[i]; }
                *(LAS f32x4*)(hT + c * 32 + ((4 * F.wave) ^ ((c & 7) << 2))) = hv;
                *(LAS f32x4*)(WrL + (size_t)(i * NTHR + tid) * 4) = wv[i]; }
            if (qt < 3) ROUTER_ISSUE(qt + 1);
            __syncthreads();
            const int tg = lane & 7, eg = lane >> 3;
#pragma unroll 8
            for (int cc = 0; cc < 64; ++cc) { const int c = F.wave * 64 + cc; const f32x4 h4 = *(const LAS f32x4*)(hT + c * 32 + ((4 * tg) ^ ((c & 7) << 2))); const f32x4 w4 = *(const LAS f32x4*)(WrL + c * 32 + 4 * eg);
#pragma unroll
                for (int a = 0; a < 4; ++a) { accr[a * 4 + 0] += h4[a] * w4.x; accr[a * 4 + 1] += h4[a] * w4.y; accr[a * 4 + 2] += h4[a] * w4.z; accr[a * 4 + 3] += h4[a] * w4.w; } }
        }
#undef ROUTER_ISSUE
        __syncthreads();
#pragma unroll
        for (int r = 0; r < 4; ++r) { const float s = wave_sum(ssl[r]); if (lane == 0) rstd_s[F.wave * 4 + r] = 1.0f / sqrtf(s * (1.0f / D) + EPS); }
#pragma unroll
        for (int q = 0; q < 16; ++q) red[(F.wave * 64 + lane) * 17 + q] = accr[q];
        __syncthreads();
        LAS float* lg = (LAS float*)(F.lds + 81920 + 36864);
        for (int o = tid; o < 1024; o += NTHR) { const int tl = o >> 5, e = o & 31; const int ln = (e >> 2) * 8 + (tl >> 2), q = (tl & 3) * 4 + (e & 3); float s = 0.f;
#pragma unroll
            for (int w = 0; w < 8; ++w) s += red[(w * 64 + ln) * 17 + q];
            lg[tl * 33 + e] = s * rstd_s[tl] + br[e]; }
        __syncthreads();
        int id[4]; float gk[4]; int lr[4];
        if (tid < 32) { const int tl = tid; float v[4]; unsigned used = 0u;
#pragma unroll
            for (int k = 0; k < 4; ++k) { float best = -3.0e38f; int bi = 0;
                for (int e = 0; e < 32; ++e) { const float x = lg[tl * 33 + e]; if (!((used >> e) & 1u) && x > best) { best = x; bi = e; } }
                used |= 1u << bi; v[k] = best; id[k] = bi; }
            const float e1 = fast_exp(v[1] - v[0]), e2 = fast_exp(v[2] - v[0]), e3 = fast_exp(v[3] - v[0]); const float inv = 1.0f / (1.0f + e1 + e2 + e3);
            gk[0] = inv; gk[1] = e1 * inv; gk[2] = e2 * inv; gk[3] = e3 * inv;
#pragma unroll
            for (int k = 0; k < 4; ++k) lr[k] = atomicAdd((int*)(lcnt + id[k]), 1);
        }
        __syncthreads();
        if (tid < 32) { const int n = lcnt[tid]; lbase[tid] = n ? atomicAdd(ecnt + tid * 64, n) : 0; }
        __syncthreads();
        if (tid < 32) { const int tl = tid;
#pragma unroll
            for (int k = 0; k < 4; ++k) { const int pos = lbase[id[k]] + lr[k]; sel_e[tl * 4 + k] = id[k]; sel_g[tl * 4 + k] = gk[k]; sel_pos[tl * 4 + k] = pos;
                slot[(size_t)(tok0 + tl) * 4 + k] = (id[k] << 16) | pos; slotg[(size_t)(tok0 + tl) * 4 + k] = gk[k]; }
            lcnt[tl] = 0; }
        __syncthreads();
#pragma unroll
        for (int r = 0; r < 4; ++r) { const int tl = F.wave * 4 + r; const float rs = rstd_s[tl]; const f32x4* xr = (const f32x4*)(x1 + (size_t)(tok0 + tl) * D) + lane;
            unsigned pk[8];
#pragma unroll
            for (int j = 0; j < 8; ++j) { const f32x4 v = xr[64 * j]; const f32x4 gg = ((const f32x4*)gmoe)[64 * j + lane];
                pk[j] = pk4_fp8(v.x * rs * gg.x, v.y * rs * gg.y, v.z * rs * gg.z, v.w * rs * gg.w); }
#pragma unroll
            for (int k = 0; k < 4; ++k) { const int e = sel_e[tl * 4 + k], pos = sel_pos[tl * 4 + k]; unsigned* o4 = (unsigned*)(Xs + ((size_t)e * CAP + pos) * D) + lane;
#pragma unroll
                for (int j = 0; j < 8; ++j) o4[64 * j] = pk[j]; } }
    }
    __syncthreads();
}

__device__ __forceinline__ void moe_table(Frame& F, volatile LAS int* tab, int NT) {
    const int lane = lane_id(), tid = F.wave * 64 + lane;
    __syncthreads();
    if (tid < 64) { const int* ecnt = (const int*)(F.ws + CTLB_ECNT); const int e = lane & 31;
        const int cnt = __hip_atomic_load(ecnt + e * 64, __ATOMIC_RELAXED, __HIP_MEMORY_SCOPE_AGENT); const int t = (cnt + 255) >> 8;
        if ((F.G & 7) == 0) { const int x = F.bx & 7; int rank = 0;
            for (int k = 0; k < 32; ++k) { const int tk = __shfl(t, k); rank += (tk > t || (tk == t && k < e)) ? 1 : 0; }
            const int rnd = rank >> 3, pos = rank & 7, g = (rnd & 1) ? 7 - pos : pos;
            if (lane < 32 && g == x) { tab[40 + rnd] = t; tab[48 + rnd] = e; }
            LDS_WAIT(); asm volatile("" ::: "memory");
            if (lane == 0) { int pre = 0; tab[0] = 0; for (int j = 0; j < 4; ++j) { pre += tab[40 + j] * NT; tab[j + 1] = pre; } }
        } else { int pre = t * NT;
#pragma unroll
            for (int o = 1; o < 32; o <<= 1) { const int v = __shfl_up(pre, o); if ((lane & 31) >= o) pre += v; }
            if (lane < 32) { tab[e + 1] = pre; tab[40 + e] = t; tab[80 + e] = e; if (e == 0) tab[0] = 0; } }
    }
    __syncthreads();
}

__device__ __forceinline__ void p11_combine(Frame& F) {
    const int lane = lane_id(), tid = F.wave * 64 + lane; (void)tid;
    const int gw = F.bx * NWAVES + F.wave, NGW = F.G * NWAVES;
    const float* x1 = (const float*)(F.ws + WS_X1); const bf16* Ye = (const bf16*)(F.ws + WS_YE); const int* slot = (const int*)(F.ws + WS_SLOT); const float* slotg = (const float*)(F.ws + WS_SLOT + 128 * 1024);
    const float* gf = INP(21); float* outp = OUTP();
    for (int tok0 = gw; tok0 < T; tok0 += 2 * NGW) {
        const int tokb = (tok0 + NGW < T) ? tok0 + NGW : tok0; int sl[2][4]; float gk[2][4];
#pragma unroll
        for (int q = 0; q < 2; ++q) { const int tok = q ? tokb : tok0; const int4 s4 = *(const int4*)(slot + (size_t)tok * 4); const f32x4 g4 = *(const f32x4*)(slotg + (size_t)tok * 4);
            sl[q][0] = s4.x; sl[q][1] = s4.y; sl[q][2] = s4.z; sl[q][3] = s4.w; gk[q][0] = g4.x; gk[q][1] = g4.y; gk[q][2] = g4.z; gk[q][3] = g4.w; }
        f32x4 v[2][8]; unsigned long long y[2][4][8];
#pragma unroll
        for (int q = 0; q < 2; ++q) { const int tok = q ? tokb : tok0; const f32x4* xr = (const f32x4*)(x1 + (size_t)tok * D) + lane;
#pragma unroll
            for (int j = 0; j < 8; ++j) v[q][j] = xr[64 * j]; }
#pragma unroll
        for (int q = 0; q < 2; ++q)
#pragma unroll
            for (int k = 0; k < 4; ++k) { const int e = sl[q][k] >> 16, pos = sl[q][k] & 0xffff; const unsigned long long* yr = (const unsigned long long*)(Ye + ((size_t)e * CAP + pos) * D) + lane;
#pragma unroll
                for (int j = 0; j < 8; ++j) y[q][k][j] = yr[64 * j]; }
#pragma unroll
        for (int q = 0; q < 2; ++q) { const int tok = q ? tokb : tok0;
#pragma unroll
            for (int k = 0; k < 4; ++k)
#pragma unroll
                for (int j = 0; j < 8; ++j) { const unsigned lo = (unsigned)y[q][k][j], hi = (unsigned)(y[q][k][j] >> 32); const float g = gk[q][k];
                    v[q][j].x += g * bflo(lo); v[q][j].y += g * bfhi(lo); v[q][j].z += g * bflo(hi); v[q][j].w += g * bfhi(hi); }
            float s = 0.f;
#pragma unroll
            for (int j = 0; j < 8; ++j) s += (v[q][j].x * v[q][j].x + v[q][j].y * v[q][j].y) + (v[q][j].z * v[q][j].z + v[q][j].w * v[q][j].w);
            const float rstd = 1.0f / sqrtf(wave_sum(s) * (1.0f / D) + EPS);
            f32x4* orow = (f32x4*)(outp + (size_t)tok * D) + lane;
            if (q == 0 || tokb != tok0) {
#pragma unroll
                for (int j = 0; j < 8; ++j) { const f32x4 gg = ((const f32x4*)gf)[64 * j + lane]; orow[64 * j] = v[q][j] * rstd * gg; } } }
    }
}

constexpr int N_PHASES = 13;
__global__ void __launch_bounds__(NTHR, 2) mk_fwd(Args args) {
    extern __shared__ __attribute__((aligned(16))) unsigned char lds_raw[];
    Frame F; F.lds = (LAS unsigned char*)lds_raw; F.wave = __builtin_amdgcn_readfirstlane((int)threadIdx.x >> 6); F.G = gridDim.x; F.bx = blockIdx.x;
    const int tid = F.wave * 64 + lane_id();
    F.ws = WSP();
    volatile LAS unsigned* MISC = (volatile LAS unsigned*)(F.lds + MISC_OFF);
    for (int i = tid; i < 256; i += NTHR) MISC[i] = 0u;
    __syncthreads();
    if (MK_N_LAUNCHES == 1) (void)xcd_barrier_post((unsigned*)(F.ws + WS_CTL) + 4096, MISC, tid == 0);
#define GRIDBAR() do { XcdBarrier _b; _b.bar = (unsigned*)(WSP() + WS_CTL) + 4096; _b.x = xb_xcc_id(); _b.st = (volatile LAS unsigned*)(F.lds + MISC_OFF); _b.G = (unsigned)F.G; xcd_barrier(_b, F.wave); } while (0)
    const int lo = args.ph_lo, hi = args.ph_hi;
#ifdef PH_ONLY
#define IN(k) ((k) == PH_ONLY && lo <= (k) && (k) < hi)
#else
#define IN(k) (lo <= (k) && (k) < hi)
#endif
#define SEAM(k) do { if (IN(k) && IN((k) + 1)) GRIDBAR(); } while (0)
#ifdef PROBE_DUP
#define REP(k) for (int _r = 0; _r < ((k) == PROBE_DUP ? 2 : 1); ++_r, ((k) == PROBE_DUP && _r == 1) ? ({ GRIDBAR(); }) : (void)0)
#else
#define REP(k)
#endif
    LAS unsigned char* ring = F.lds;
    if (lane_id() == 0) *((volatile LAS int*)(F.lds + MISC_OFF + 3072) + F.wave) = 0;
#define MKHOOK() const ConvHook HK{INP(17), INP(19), (unsigned char*)(F.ws + WS_WGU), (unsigned char*)(F.ws + WS_WD), (volatile LAS int*)(F.lds + MISC_OFF + 3072) + F.wave, F.bx * NWAVES + F.wave, F.G * NWAVES}
    volatile LAS int* tab = (volatile LAS int*)(F.lds + MISC_OFF + 4096);

    if (IN(0)) REP(0) { F.ws = WSP(); unsigned char* const ws = F.ws; (void)ws; p0_prologue(F); } SEAM(0);
    if (IN(1)) REP(1) { F.ws = WSP(); unsigned char* const ws = F.ws; (void)ws;
        EpiIn E{INP(3), ws};
        MKHOOK(); const int grp3 = (F.bx >> 3) % 3; if (grp3 == 0) HK.run(CONV_ITEMS_PER_WAVE, lane_id());
        { SchedGrid S{(const char*)(ws + WS_H), (const char*)(ws + WS_WIN), 4096u, 4096u, 32, N_BF16_TILES, F.G, F.bx, 32};
          pg8::gemm_phase<EpiIn, SchedGrid, ConvHook>(ring, F.wave, pg8::Gemm{4096u, 4096u}, S, E, HK, grp3 == 1 ? CONV_ITEMS_PER_WAVE : 0, 2); }
        { SchedGrid S{(const char*)(ws + WS_H8), (const char*)(ws + WS_WIN8), 2048u, 2048u, 32, N_FP8_TILES, F.G, F.bx, 16, N_BF16_TILES};
          pg8::gemm_phase<EpiIn, SchedGrid, ConvHook, true>(ring, F.wave, pg8::Gemm{2048u, 2048u}, S, E, HK, grp3 == 2 ? CONV_ITEMS_PER_WAVE : 0, -2); }
    } SEAM(1);
    if (IN(2)) REP(2) { F.ws = WSP(); unsigned char* const ws = F.ws; (void)ws; p2_elementwise(F); } SEAM(2);
    if (IN(3)) REP(3) { F.ws = WSP(); unsigned char* const ws = F.ws; (void)ws;
        SchedSgu S{(const char*)(ws + WS_WBD), (const char*)(ws + WS_VGT), F.G, F.bx};
        EpiSgu E{(const bf16*)(ws + WS_UG), INP(7), (bf16*)(ws + WS_Y)};
        MKHOOK(); pg8::gemm_phase<EpiSgu, SchedSgu, ConvHook>(ring, F.wave, pg8::Gemm{512u, 4096u}, S, E, HK, 0);
    }
    if (IN(4)) REP(4) { F.ws = WSP(); unsigned char* const ws = F.ws; (void)ws;
        SchedQK S{(const char*)(ws + WS_QKC), F.G, F.bx};
        EpiQK E{(const float*)(ws + WS_AS), (const float*)(ws + WS_MT), (bf16*)(ws + WS_P), (float*)(ws + WS_DENP)};
        const ConvPoolB HP{INP(11), INP(12), INP(13), (bf16*)(ws + WS_PAM), (bf16*)(ws + WS_WOUT), ((F.bx - 64) * NWAVES + F.wave) * 2, (F.G == 256 && F.bx >= 64) ? 2 : 0};
        pg8::gemm_phase<EpiQK, SchedQK, ConvPoolB>(ring, F.wave, pg8::Gemm{8192u, 8192u}, S, E, HP, 1, -2);
    } SEAM(4);
    if (IN(5)) REP(5) { F.ws = WSP(); unsigned char* const ws = F.ws; (void)ws;
        SchedPV S{(const char*)(ws + WS_P), (const char*)(ws + WS_VMT), F.G, F.bx};
        EpiPV E{(const float*)(ws + WS_DENP), (const float*)(ws + WS_BM), (bf16*)(ws + WS_HM), (float*)(ws + WS_SSQP)};
        MKHOOK(); const int g5 = (F.bx >> 5) & 7, n5 = (int)((CONV_P5_N >> (4 * g5)) & 15u), pre5 = (int)((CONV_P5_PRE >> (8 * g5)) & 255ull);
        const ConvPool HP{HK, CONV_POOL5 + 256 * pre5 + ((F.bx & 31) * NWAVES + F.wave) * n5, (F.G == 256) ? n5 : 0};
        pg8::gemm_phase<EpiPV, SchedPV, ConvPool>(ring, F.wave, pg8::Gemm{4096u, 4096u}, S, E, HP, 1, -2);
    } SEAM(5);
    if (IN(6)) REP(6) { F.ws = WSP(); unsigned char* const ws = F.ws; (void)ws; p5_ym(F); } SEAM(6);
    if (IN(7)) REP(7) { F.ws = WSP(); unsigned char* const ws = F.ws; (void)ws;
        SchedMerge S{(const char*)(ws + WS_Y), (const char*)(ws + WS_PAM), F.G, F.bx};
        EpiMerge E{(const bf16*)(ws + WS_GA), (const bf16*)(ws + WS_GM), (bf16*)(ws + WS_MRG)};
        MKHOOK(); pg8::gemm_phase<EpiMerge, SchedMerge, ConvHook>(ring, F.wave, pg8::Gemm{8192u, 8192u}, S, E, HK, 0);
    } SEAM(7);
    if (IN(8)) REP(8) { F.ws = WSP(); unsigned char* const ws = F.ws; (void)ws;
        SchedGrid S{(const char*)(ws + WS_MRG), (const char*)(ws + WS_WOUT), 4096u, 4096u, 32, 8, F.G, F.bx, 32};
        EpiX1 E{INP(0), (float*)(ws + WS_X1)};
        MKHOOK(); pg8::gemm_phase<EpiX1, SchedGrid, ConvHook>(ring, F.wave, pg8::Gemm{4096u, 4096u}, S, E, HK, 0);
    } SEAM(8);
    if (IN(9)) REP(9) { F.ws = WSP(); unsigned char* const ws = F.ws; (void)ws; p8_router(F); MKHOOK(); HK.run(1000, lane_id()); } SEAM(9);
    if (IN(10)) REP(10) { F.ws = WSP(); unsigned char* const ws = F.ws; (void)ws;
        moe_table(F, tab, 16);
        { SchedMoe2 S{(const char*)(ws + WS_XS), (const char*)(ws + WS_HA), (const char*)(ws + WS_WGU), (const char*)(ws + WS_WD), tab, F.G, F.bx, nullptr, nullptr, 0};
          EpiGU E{INP(18), (unsigned char*)(ws + WS_HA)};
          pg8::gemm_phase<EpiGU, SchedMoe2, NoHook, true>(ring, F.wave, pg8::Gemm{2048u, 2048u}, S, E); }
    } SEAM(10);
    if (IN(11)) REP(11) { F.ws = WSP(); unsigned char* const ws = F.ws; (void)ws;
        { SchedMoe2 S{(const char*)(ws + WS_XS), (const char*)(ws + WS_HA), (const char*)(ws + WS_WGU), (const char*)(ws + WS_WD), tab, F.G, F.bx, nullptr, nullptr, 1};
          EpiDown E{INP(20), (bf16*)(ws + WS_YE)};
          pg8::gemm_phase<EpiDown, SchedMoe2, NoHook, true>(ring, F.wave, pg8::Gemm{2048u, 2048u}, S, E); }
    }
    SEAM(11);
    if (IN(12)) REP(12) { F.ws = WSP(); unsigned char* const ws = F.ws; (void)ws; p11_combine(F); }
#undef IN
#undef SEAM
}

extern "C" void kernel_launch(void* const* d_in, const int* in_sizes, int n_in, void* d_out, int out_size, void* d_ws, size_t ws_size, hipStream_t stream) {
    static int grid = 0;
    if (grid == 0) {
        if (n_in != 22 || out_size != T * D || ws_size < WS_END) { fprintf(stderr, "kernel_launch: unexpected shapes (n_in %d out %d ws %zu need %zu)\n", n_in, out_size, ws_size, (size_t)WS_END); grid = -1; return; }
        int dev = 0, cus = 0, per_cu = 0;
        if (hipGetDevice(&dev) != hipSuccess || hipDeviceGetAttribute(&cus, hipDeviceAttributeMultiprocessorCount, dev) != hipSuccess) { grid = -1; return; }
        if (hipFuncSetAttribute((const void*)mk_fwd, hipFuncAttributeMaxDynamicSharedMemorySize, LDS_BYTES) != hipSuccess) { fprintf(stderr, "kernel_launch: hipFuncSetAttribute failed\n"); grid = -1; return; }
        if (hipOccupancyMaxActiveBlocksPerMultiprocessor(&per_cu, (const void*)mk_fwd, NTHR, LDS_BYTES) != hipSuccess || per_cu < 1) fprintf(stderr, "kernel_launch: occupancy query says %d\n", per_cu);
        (void)hipGetLastError();
        grid = cus;
    }
    if (grid < 0) return;
    (void)in_sizes;
    hipMemsetAsync((char*)d_ws + WS_CTL, 0, CTL_ZERO_BYTES, stream);
    Args a{};
    for (int i = 0; i < 22; ++i) a.in[i] = (const float*)d_in[i];
    a.out = (float*)d_out; a.ws = (unsigned char*)d_ws;
    if (MK_N_LAUNCHES == 1) { a.ph_lo = 0; a.ph_hi = N_PHASES; a.li = 0; hipLaunchKernelGGL(mk_fwd, dim3(grid), dim3(NTHR), LDS_BYTES, stream, a); }
    else { for (int p = 0; p < N_PHASES; ++p) { a.ph_lo = p; a.ph_hi = p + 1; a.li = p; hipLaunchKernelGGL(mk_fwd, dim3(grid), dim3(NTHR), LDS_BYTES, stream, a); } }
}
```
